# Optimizing an MI355X kernel written in HIP

```python
import math
import jax
import jax.numpy as jnp
from jax import lax
import numpy as np

D_MODEL = 2048
BATCH = 1
SEQ = 16384
DEPTH = 2

HEAD_DIM = 128
N_HEADS = D_MODEL // HEAD_DIM
BLOCK = 128
GRID_W = 64
ROW_WIN = 8
COL_WIN = 16
A_HEADS = N_HEADS // 2
B_HEADS = N_HEADS // 2
DIFF_QK_DIM = HEAD_DIM // 2
LAMBDA_INIT = 0.2
C_HEADS = N_HEADS // 2
C_PATTERNS = ((128, 1), (512, 4), (2048, 16))
C_GROUPS = len(C_PATTERNS)
D_HEADS = N_HEADS // 2
D_KV_HEADS = D_HEADS // 4
D_HALF_WINDOW = 128
ROPE_THETA = 500000.0
ROPE_FRACTION = 4
RMS_EPS = 1e-6
NEG_INF = -1e30

EVEN_IN_WIDTHS = (
    A_HEADS * HEAD_DIM, A_HEADS * HEAD_DIM, A_HEADS * HEAD_DIM, A_HEADS * HEAD_DIM,
    B_HEADS * 2 * DIFF_QK_DIM, B_HEADS * 2 * DIFF_QK_DIM, B_HEADS * HEAD_DIM, B_HEADS * HEAD_DIM,
)
EVEN_OUT = A_HEADS * HEAD_DIM + B_HEADS * HEAD_DIM
ODD_IN_WIDTHS = (
    C_GROUPS * C_HEADS * HEAD_DIM, C_GROUPS * C_HEADS * HEAD_DIM, C_GROUPS * C_HEADS * HEAD_DIM, C_HEADS * HEAD_DIM,
    D_HEADS * HEAD_DIM, D_KV_HEADS * HEAD_DIM, D_KV_HEADS * HEAD_DIM, D_HEADS * HEAD_DIM,
)
ODD_OUT = C_HEADS * HEAD_DIM + D_HEADS * HEAD_DIM

kernel_name = "hybrid_natten_diff_dilated_swa_encoder"


def rms_norm(x, g):
    xf = x.astype(jnp.float32)
    y = xf * lax.rsqrt(jnp.mean(xf * xf, axis=-1, keepdims=True) + RMS_EPS)
    return y.astype(x.dtype) * g


def _split(t, widths):
    out, start = [], 0
    for w in widths:
        out.append(t[..., start:start + w])
        start += w
    return out


def partial_rope(x, pos):
    dh = x.shape[-1]
    rd = dh // ROPE_FRACTION
    half = rd // 2
    inv = ROPE_THETA ** (-jnp.arange(half, dtype=jnp.float32) / half)
    ang = pos.astype(jnp.float32)[:, None] * inv[None, :]
    shape = (1, x.shape[1]) + (1,) * (x.ndim - 3) + (half,)
    cos = jnp.cos(ang).reshape(shape)
    sin = jnp.sin(ang).reshape(shape)
    xr = x[..., :rd].astype(jnp.float32)
    x1, x2 = xr[..., :half], xr[..., half:]
    rot = jnp.concatenate([x1 * cos - x2 * sin, x2 * cos + x1 * sin], axis=-1)
    return jnp.concatenate([rot.astype(x.dtype), x[..., rd:]], axis=-1)


def neighbourhood_attention(q, k, v, rpb):
    b, s, h, dh = q.shape
    rows = s // GRID_W
    wr = min(ROW_WIN, rows)
    r = jnp.arange(rows)
    row_start = jnp.clip(r - ROW_WIN // 2, 0, rows - wr)
    row_idx = row_start[:, None] + jnp.arange(wr)[None, :]
    qg = q.reshape(b, rows, GRID_W, h, dh)
    kg = k.reshape(b, rows, GRID_W, h, dh)[:, row_idx]
    vg = v.reshape(b, rows, GRID_W, h, dh)[:, row_idx]
    sc = jnp.einsum("brchd,brjkhd->brhcjk", qg, kg).astype(jnp.float32) * (dh ** -0.5)
    c = jnp.arange(GRID_W)
    col_start = jnp.clip(c - COL_WIN // 2, 0, GRID_W - COL_WIN)
    col_ok = (c[None, :] >= col_start[:, None]) & (c[None, :] < col_start[:, None] + COL_WIN)
    dr_i = row_idx - r[:, None] + ROW_WIN - 1
    dc_i = jnp.clip(c[None, :] - c[:, None] + COL_WIN - 1, 0, 2 * COL_WIN - 2)
    bias = rpb[:, dr_i][:, :, :, dc_i]
    bias = bias.transpose(1, 0, 3, 2, 4).astype(jnp.float32)
    sc = jnp.where(col_ok[:, None, :], sc + bias[None], NEG_INF)
    p = jax.nn.softmax(sc, axis=(-2, -1))
    o = jnp.einsum("brhcjk,brjkhd->brchd", p.astype(v.dtype), vg)
    return o.reshape(b, s, h, dh)


def diff_attention(q, k, v, lam):
    b, s, h, _, dq = q.shape
    dv = v.shape[-1]
    nb = s // BLOCK
    qb = jnp.moveaxis(q.reshape(b, nb, BLOCK, h, 2, dq), 1, 0)

    def one_block(qblk):
        sc = jnp.einsum("bqhcd,bkhcd->bchqk", qblk, k).astype(jnp.float32) * (dq ** -0.5)
        p = jax.nn.softmax(sc, axis=-1)
        a = p[:, 0] - lam * p[:, 1]
        return jnp.einsum("bhqk,bkhd->bqhd", a.astype(v.dtype), v)

    o = lax.map(one_block, qb)
    return jnp.moveaxis(o, 0, 1).reshape(b, s, h, dv)


def banded_attention(q, k, v, half):
    n, L, hk, g, dh = q.shape
    nb = -(-L // BLOCK)
    lp = nb * BLOCK
    kb = BLOCK + 2 * half
    qp = jnp.pad(q, ((0, 0), (0, lp - L), (0, 0), (0, 0), (0, 0)))
    pad_kv = ((0, 0), (half, lp - L + half), (0, 0), (0, 0))
    kp = jnp.pad(k, pad_kv)
    vp = jnp.pad(v, pad_kv)
    blk = jnp.arange(nb)[:, None] * BLOCK
    key_idx = blk + jnp.arange(kb)[None, :]
    k_blk = kp[:, key_idx]
    v_blk = vp[:, key_idx]
    q_blk = qp.reshape(n, nb, BLOCK, hk, g, dh)
    sc = jnp.einsum("nbqhgd,nbkhd->nbhgqk", q_blk, k_blk).astype(jnp.float32) * (dh ** -0.5)
    q_pos = blk + jnp.arange(BLOCK)[None, :]
    k_pos = key_idx - half
    valid = ((jnp.abs(q_pos[:, :, None] - k_pos[:, None, :]) <= half)
             & ((k_pos >= 0) & (k_pos < L))[:, None, :])
    sc = jnp.where(valid[None, :, None, None], sc, NEG_INF)
    lse = jax.nn.logsumexp(sc, axis=-1)
    p = jnp.exp(sc - lse[..., None])
    o = jnp.einsum("nbhgqk,nbkhd->nbqhgd", p.astype(v.dtype), v_blk)
    o = o.reshape(n, lp, hk, g, dh)[:, :L]
    lse = lse.transpose(0, 1, 4, 2, 3).reshape(n, lp, hk, g)[:, :L]
    return o, lse


def _fold(t, dil):
    b, s = t.shape[:2]
    rest = t.shape[2:]
    return t.reshape((b, s // dil, dil) + rest).swapaxes(1, 2).reshape((b * dil, s // dil) + rest)


def _unfold(t, b, dil):
    n, l = t.shape[:2]
    rest = t.shape[2:]
    return t.reshape((b, dil, l) + rest).swapaxes(1, 2).reshape((b, l * dil) + rest)


def dilated_mixture_attention(q, k, v):
    b = q.shape[0]
    outs, lses = [], []
    for gi, (window, dil) in enumerate(C_PATTERNS):
        half = (window // 2) // dil
        o, lse = banded_attention(_fold(q[:, :, gi], dil)[:, :, :, None],
                                  _fold(k[:, :, gi], dil), _fold(v[:, :, gi], dil), half)
        outs.append(_unfold(o[:, :, :, 0], b, dil))
        lses.append(_unfold(lse[:, :, :, 0], b, dil))
    w = jax.nn.softmax(jnp.stack(lses, axis=0), axis=0)
    o = jnp.stack(outs, axis=0)
    return jnp.sum(w[..., None].astype(o.dtype) * o, axis=0)


def even_layer(x, pre_g, w_in, rpb, lam_q1, lam_k1, lam_q2, lam_k2, subln_g, w_out, post_g):
    b, s, _ = x.shape
    pos = jnp.arange(s)
    h = rms_norm(x, pre_g)
    qa, ka, va, ga, qb, kb, vb, gb = _split(h @ w_in, EVEN_IN_WIDTHS)
    oa = neighbourhood_attention(qa.reshape(b, s, A_HEADS, HEAD_DIM), ka.reshape(b, s, A_HEADS, HEAD_DIM),
                                 va.reshape(b, s, A_HEADS, HEAD_DIM), rpb)
    qb = partial_rope(qb.reshape(b, s, B_HEADS, 2, DIFF_QK_DIM), pos)
    kb = partial_rope(kb.reshape(b, s, B_HEADS, 2, DIFF_QK_DIM), pos)
    lam = (jnp.exp(jnp.sum(lam_q1.astype(jnp.float32) * lam_k1.astype(jnp.float32)))
           - jnp.exp(jnp.sum(lam_q2.astype(jnp.float32) * lam_k2.astype(jnp.float32))) + LAMBDA_INIT)
    ob = diff_attention(qb, kb, vb.reshape(b, s, B_HEADS, HEAD_DIM), lam)
    ob = rms_norm(ob, subln_g) * (1.0 - LAMBDA_INIT)
    mix = jnp.concatenate([oa.reshape(b, s, -1) * jax.nn.silu(ga),
                           ob.reshape(b, s, -1) * jax.nn.silu(gb)], axis=-1)
    return x + rms_norm(mix @ w_out, post_g)


def odd_layer(x, pre_g, w_in, sink, w_out, post_g):
    b, s, _ = x.shape
    pos = jnp.arange(s)
    h = rms_norm(x, pre_g)
    qc, kc, vc, gc, qd, kd, vd, gd = _split(h @ w_in, ODD_IN_WIDTHS)
    qc = partial_rope(qc.reshape(b, s, C_GROUPS, C_HEADS, HEAD_DIM), pos)
    kc = partial_rope(kc.reshape(b, s, C_GROUPS, C_HEADS, HEAD_DIM), pos)
    oc = dilated_mixture_attention(qc, kc, vc.reshape(b, s, C_GROUPS, C_HEADS, HEAD_DIM))
    grp = D_HEADS // D_KV_HEADS
    qd = partial_rope(qd.reshape(b, s, D_HEADS, HEAD_DIM), pos).reshape(b, s, D_KV_HEADS, grp, HEAD_DIM)
    kd = partial_rope(kd.reshape(b, s, D_KV_HEADS, HEAD_DIM), pos)
    od, lse = banded_attention(qd, kd, vd.reshape(b, s, D_KV_HEADS, HEAD_DIM), D_HALF_WINDOW)
    sink_f = sink.astype(jnp.float32).reshape(D_KV_HEADS, grp)
    od = od * jnp.exp(lse - jnp.logaddexp(lse, sink_f))[..., None].astype(od.dtype)
    mix = jnp.concatenate([oc.reshape(b, s, -1) * jax.nn.silu(gc),
                           od.reshape(b, s, -1) * jax.nn.silu(gd)], axis=-1)
    return x + rms_norm(mix @ w_out, post_g)


def setup_inputs(seed: int = 0) -> dict:
    key = jax.random.key(seed)
    ks = jax.random.split(key, 16)
    d = D_MODEL

    def nrm(k, shape, scale):
        return jax.random.normal(k, shape, jnp.float32) * scale

    even_in = sum(EVEN_IN_WIDTHS)
    odd_in = sum(ODD_IN_WIDTHS)
    return {
        "x": nrm(ks[0], (BATCH, SEQ, D_MODEL), 1.0),
        "l0_pre_g": 1.0 + nrm(ks[1], (d,), 0.05),
        "l0_w_in": nrm(ks[2], (d, even_in), d ** -0.5),
        "l0_rpb": nrm(ks[3], (A_HEADS, 2 * ROW_WIN - 1, 2 * COL_WIN - 1), 0.5),
        "l0_lam_q1": nrm(ks[4], (DIFF_QK_DIM,), 0.1),
        "l0_lam_k1": nrm(ks[5], (DIFF_QK_DIM,), 0.1),
        "l0_lam_q2": nrm(ks[6], (DIFF_QK_DIM,), 0.1),
        "l0_lam_k2": nrm(ks[7], (DIFF_QK_DIM,), 0.1),
        "l0_subln_g": 1.0 + nrm(ks[8], (HEAD_DIM,), 0.05),
        "l0_w_out": nrm(ks[9], (EVEN_OUT, d), EVEN_OUT ** -0.5),
        "l0_post_g": 1.0 + nrm(ks[10], (d,), 0.05),
        "l1_pre_g": 1.0 + nrm(ks[11], (d,), 0.05),
        "l1_w_in": nrm(ks[12], (d, odd_in), d ** -0.5),
        "l1_sink": nrm(ks[13], (D_HEADS,), 1.0),
        "l1_w_out": nrm(ks[14], (ODD_OUT, d), ODD_OUT ** -0.5),
        "l1_post_g": 1.0 + nrm(ks[15], (d,), 0.05),
    }


def reference(x, l0_pre_g, l0_w_in, l0_rpb, l0_lam_q1, l0_lam_k1, l0_lam_q2, l0_lam_k2,
              l0_subln_g, l0_w_out, l0_post_g, l1_pre_g, l1_w_in, l1_sink, l1_w_out, l1_post_g):
    layer_params = (
        (l0_pre_g, l0_w_in, l0_rpb, l0_lam_q1, l0_lam_k1, l0_lam_q2, l0_lam_k2, l0_subln_g, l0_w_out, l0_post_g),
        (l1_pre_g, l1_w_in, l1_sink, l1_w_out, l1_post_g),
    )
    for layer in range(DEPTH):
        if layer % 2 == 0:
            x = even_layer(x, *layer_params[layer])
        else:
            x = odd_layer(x, *layer_params[layer])
    return x
```

```cpp
#include <hip/hip_runtime.h>
#include <hip/hip_cooperative_groups.h>
#include <cstdio>
#include <cstdint>
#include <cmath>
namespace cg = cooperative_groups;

#define LAS __attribute__((address_space(3)))
typedef unsigned short bf16_t;
typedef short bf16x8 __attribute__((ext_vector_type(8)));
typedef float f32x4 __attribute__((ext_vector_type(4)));
typedef float f32x2 __attribute__((ext_vector_type(2)));
typedef float f32x16 __attribute__((ext_vector_type(16)));
typedef unsigned u32x4 __attribute__((ext_vector_type(4)));
typedef unsigned u32x2 __attribute__((ext_vector_type(2)));
typedef __bf16 bf16x2_t __attribute__((ext_vector_type(2)));

constexpr int S = 16384, DM = 2048;
constexpr size_t MiB = 1u << 20;
constexpr size_t WS_PROJ = 0;
constexpr size_t WS_VT0 = 192 * MiB;
constexpr size_t WS_VT1 = 296 * MiB;
constexpr size_t WS_H0R0 = 400 * MiB;
constexpr size_t WS_BT0 = 464 * MiB;
constexpr size_t WS_WV0 = 488 * MiB;
constexpr size_t WS_BO0 = 496 * MiB;
constexpr size_t WS_BO1 = 504 * MiB;
constexpr size_t WS_NEED = 512 * MiB;
constexpr size_t DO_MIX = 0;
constexpr size_t DO_BT1 = 64 * MiB;
constexpr size_t DO_WV1 = 101 * MiB;
constexpr size_t DO_TAB0 = 114 * MiB;
constexpr size_t DO_TAB1 = 115 * MiB;
constexpr size_t DO_LSE = 117 * MiB;

constexpr int LD0 = 6144, LD1 = 9472;
constexpr float LOG2E = 1.4426950408889634f;
constexpr float SC128 = 0.08838834764831845f * 1.4426950408889634f;
constexpr float SC64 = 0.125f * 1.4426950408889634f;

struct Params {
    const float* in[16];
    float* out; unsigned char* ws;
    float inv0[8]; float inv1[16];
    int ph_lo, ph_hi;
};
#if defined(__HIP_DEVICE_COMPILE__)
typedef __attribute__((address_space(4))) const Params KParams;
#else
typedef const Params KParams;
#endif

__device__ __forceinline__ unsigned cvtpk(float lo, float hi) { f32x2 v = {lo, hi}; bf16x2_t b = __builtin_convertvector(v, bf16x2_t); return __builtin_bit_cast(unsigned, b); }
__device__ __forceinline__ float bf2f(unsigned short b) { return __uint_as_float(((unsigned)b) << 16); }
__device__ __forceinline__ float bflo(unsigned w) { return __uint_as_float(w << 16); }
__device__ __forceinline__ float bfhi(unsigned w) { return __uint_as_float(w & 0xffff0000u); }
__device__ __forceinline__ float wave_sum(float v) {
#pragma unroll
    for (int o = 1; o < 64; o <<= 1) v += __shfl_xor(v, o);
    return v;
}
__device__ __forceinline__ float xhalf_sum(float v) { auto rr = __builtin_amdgcn_permlane32_swap(__float_as_uint(v), __float_as_uint(v), false, false); return __uint_as_float(rr[0]) + __uint_as_float(rr[1]); }
__device__ __forceinline__ float silu_f(float x) { return x * __builtin_amdgcn_rcpf(1.0f + __builtin_amdgcn_exp2f(-x * LOG2E)); }

namespace pg8 {
constexpr int BM = 256, BK = 64, HALF = 128, HTB = HALF * BK * 2, STAGE_BYTES = 8 * HTB, NXCD = 8, WGM = 8;
__host__ __device__ __forceinline__ int lds_byte(int r, int c) { const int st = (r >> 4) * 2 + (c >> 5), rr = r & 15, cc = c & 31, ob = rr * 64 + cc * 2; return st * 1024 + (ob ^ (((ob >> 9) & 1) << 5)); }
__host__ __device__ __forceinline__ void stage_rc(int b, int& R, int& C) { const int st = b / 1024, sb = b % 1024, swz = sb ^ (((sb >> 9) & 1) << 5); R = (st >> 1) * 16 + swz / 64; C = (st & 1) * 32 + (swz % 64) / 2; }
__host__ __device__ __forceinline__ int perm32(int rho) { const int n = rho >> 4, i = rho & 15; return 8 * (i >> 2) + 4 * n + (i & 3); }

struct Unit { int pm, pn; };
struct Gemm { const bf16_t* A; const bf16_t* Bt; int M, N, K; int bdil; };

struct StaticOrder {
    int nM, nN, nwg, G, c;
    __device__ void init(int M, int N, int G_, int c_) { nM = M / BM; nN = N / BM; nwg = nM * nN; G = G_; c = c_; }
    __device__ bool next(int i, Unit& u) const {
        const long L = (long)i * G + c; if (L >= nwg) return false;
        int wgid = (int)L; { const int q = nwg / NXCD, r = nwg % NXCD, xcd = wgid % NXCD, off = wgid / NXCD; wgid = (xcd < r ? xcd * (q + 1) : r * (q + 1) + (xcd - r) * q) + off; }
        const int nig = WGM * nN, gid = wgid / nig, fm = gid * WGM, gsz = (nM - fm) < WGM ? (nM - fm) : WGM;
        u.pm = fm + ((wgid % nig) % gsz); u.pn = (wgid % nig) / gsz; return true;
    }
};


struct EpiMain {
    static constexpr bool PERM = true;
    bf16_t* O; int ldc; const float* tab; int layer; unsigned* kinf;
    __device__ __forceinline__ void operator()(const f32x4 (&acc)[2][2][4][2], const Unit& u, int wr, int wc, int fr, int fq) const {
#pragma unroll
        for (int bj = 0; bj < 2; ++bj) {
            const int blk = 2 * u.pn + bj;
            const bool do_kmax = (layer == 0) && (blk >= 32) && (blk < 40);
            float amax = 0.f;
            int rope = 0; float sc = 1.f;
            if (layer == 0) { if (blk < 8) sc = SC128; else if (blk >= 24 && blk < 32) { rope = 1; sc = SC64; } else if (blk >= 32 && blk < 40) rope = 1; }
            else { if (blk < 24) { rope = 2; sc = SC128; } else if (blk < 48) rope = 2; else if (blk >= 56 && blk < 64) { rope = 2; sc = SC128; } else if (blk >= 64 && blk < 66) rope = 2; }
            const bool do_rope = (rope == 1 && (wc & 1) == 0) || (rope == 2 && wc == 0);
            const int col0 = u.pn * BM + bj * HALF + wc * 32 + 8 * fq;
#pragma unroll
            for (int ai = 0; ai < 2; ++ai)
#pragma unroll
                for (int m = 0; m < 4; ++m) {
                    const int row = u.pm * BM + ai * HALF + wr * 64 + m * 16 + fr;
                    float v[8];
#pragma unroll
                    for (int k = 0; k < 4; ++k) { v[k] = acc[ai][bj][m][0][k]; v[4 + k] = acc[ai][bj][m][1][k]; }
                    if (do_rope) {
                        const int xm = (rope == 1) ? 16 : 32;
                        float pv[8];
#pragma unroll
                        for (int k = 0; k < 8; ++k) pv[k] = __shfl_xor(v[k], xm);
                        const bool act = (rope == 1) ? (fq < 2) : true;
                        const bool isx1 = (rope == 1) ? (fq == 0) : (fq < 2);
                        const float* tp = (rope == 1) ? (tab + ((size_t)row * 8) * 2) : (tab + ((size_t)row * 16 + 8 * (fq & 1)) * 2);
                        f32x4 t0 = *(const f32x4*)(tp), t1 = *(const f32x4*)(tp + 4), t2 = *(const f32x4*)(tp + 8), t3 = *(const f32x4*)(tp + 12);
                        const float cs[8] = {t0[0], t0[2], t1[0], t1[2], t2[0], t2[2], t3[0], t3[2]};
                        const float sn[8] = {t0[1], t0[3], t1[1], t1[3], t2[1], t2[3], t3[1], t3[3]};
                        if (act) {
#pragma unroll
                            for (int k = 0; k < 8; ++k) v[k] = isx1 ? (v[k] * cs[k] - pv[k] * sn[k]) : (v[k] * cs[k] + pv[k] * sn[k]);
                        }
                    }
                    if (do_kmax) {
#pragma unroll
                        for (int k = 0; k < 8; ++k) amax = fmaxf(amax, fabsf(v[k]));
                    }
                    u32x4 w; w.x = cvtpk(v[0] * sc, v[1] * sc); w.y = cvtpk(v[2] * sc, v[3] * sc); w.z = cvtpk(v[4] * sc, v[5] * sc); w.w = cvtpk(v[6] * sc, v[7] * sc);
                    __builtin_nontemporal_store(w, (u32x4*)(O + (size_t)row * ldc + col0));
                }
            if (do_kmax) {
#pragma unroll
                for (int o = 1; o < 64; o <<= 1) amax = fmaxf(amax, __shfl_xor(amax, o));
                if (fr == 0 && fq == 0) atomicMax(kinf + (blk - 32) * 2 + (wc >> 1), __float_as_uint(amax));
            }
        }
    }
};
struct EpiVt {
    static constexpr bool PERM = true;
    bf16_t* O; int dil;
    __device__ __forceinline__ void operator()(const f32x4 (&acc)[2][2][4][2], const Unit& u, int wr, int wc, int fr, int fq) const {
        const int W = 256 / dil, L = S / dil;
#pragma unroll
        for (int ai = 0; ai < 2; ++ai)
#pragma unroll
            for (int m = 0; m < 4; ++m) {
                const int row = u.pm * BM + ai * HALF + wr * 64 + m * 16 + fr;
#pragma unroll
                for (int bj = 0; bj < 2; ++bj) {
                    const int n0 = bj * HALF + wc * 32 + 8 * fq, c = n0 / W, ll = n0 % W;
                    const f32x4 v0 = acc[ai][bj][m][0], v1 = acc[ai][bj][m][1];
                    u32x4 w; w.x = cvtpk(v0[0], v0[1]); w.y = cvtpk(v0[2], v0[3]); w.z = cvtpk(v1[0], v1[1]); w.w = cvtpk(v1[2], v1[3]);
                    __builtin_nontemporal_store(w, (u32x4*)(O + (size_t)row * S + (size_t)c * L + u.pn * W + ll));
                }
            }
    }
};
struct EpiF32 {
    static constexpr bool PERM = true;
    bf16_t* O; int ldc;
    __device__ __forceinline__ void operator()(const f32x4 (&acc)[2][2][4][2], const Unit& u, int wr, int wc, int fr, int fq) const {
#pragma unroll
        for (int ai = 0; ai < 2; ++ai)
#pragma unroll
            for (int m = 0; m < 4; ++m) {
                const int row = u.pm * BM + ai * HALF + wr * 64 + m * 16 + fr;
#pragma unroll
                for (int bj = 0; bj < 2; ++bj) {
                    const f32x4 v0 = acc[ai][bj][m][0], v1 = acc[ai][bj][m][1];
                    u32x4 w; w.x = cvtpk(v0[0], v0[1]); w.y = cvtpk(v0[2], v0[3]); w.z = cvtpk(v1[0], v1[1]); w.w = cvtpk(v1[2], v1[3]);
                    *(u32x4*)(O + (size_t)row * ldc + u.pn * BM + bj * HALF + wc * 32 + 8 * fq) = w;
                }
            }
    }
};

template <class Epi>
__device__ __forceinline__ void gemm_phase(LAS unsigned char* lds, const Gemm g, const StaticOrder& S_, const Epi& E, const int tid) {
    const int wid = __builtin_amdgcn_readfirstlane(tid >> 6), lane = tid & 63, wr = wid >> 2, wc = wid & 3, fr = lane & 15, fq = lane >> 4;
    const int K = g.K, nt = K / BK;
    unsigned voffA[2], voffB0[2], voffB1[2];
    {
        const int Wd = 256 / g.bdil;
#pragma unroll
        for (int i = 0; i < 2; ++i) { int R, C; stage_rc(tid * 16 + i * 8192, R, C); const int Rb = Epi::PERM ? ((R & ~31) + perm32(R & 31)) : R;
            voffA[i] = (unsigned)(R * K + C) * 2u;
            const int n0 = Rb, n1 = 128 + Rb;
            voffB0[i] = (unsigned)(((n0 % Wd) * g.bdil + n0 / Wd) * K + C) * 2u;
            voffB1[i] = (unsigned)(((n1 % Wd) * g.bdil + n1 / Wd) * K + C) * 2u; }
    }
    const size_t kstep = (size_t)(BK * 2);
    const size_t hstep = (size_t)HALF * K * 2;
    const size_t tstep = 2 * hstep;
    const unsigned ldsw = (unsigned)wid * 1024u;
    const int aoff = lds_byte(wr * 64 + fr, fq * 8), boff = lds_byte(wc * 32 + fr, fq * 8);
#define PG8_SA(b, h) (((b) * 2 + (h)) * HTB)
#define PG8_SB(b, h) ((4 + (b) * 2 + (h)) * HTB)
#define PG8_STAGE(bufoff, gbase, voff) do { _Pragma("unroll") for (int _i = 0; _i < 2; ++_i) \
        __builtin_amdgcn_global_load_lds((const unsigned*)((const char*)(gbase) + (voff)[_i]), (LAS unsigned*)(lds + (bufoff) + ldsw + _i * 8192), 16, 0, 0); } while (0)
#define PG8_LDA(dst, b, h) do { _Pragma("unroll") for (int m = 0; m < 4; ++m) _Pragma("unroll") for (int k = 0; k < 2; ++k) dst[m][k] = *(const LAS bf16x8*)(lds + PG8_SA(b, h) + aoff + m * 2048 + k * 1024); } while (0)
#define PG8_LDB(dst, b, h) do { _Pragma("unroll") for (int n = 0; n < 2; ++n) _Pragma("unroll") for (int k = 0; k < 2; ++k) dst[n][k] = *(const LAS bf16x8*)(lds + PG8_SB(b, h) + boff + n * 2048 + k * 1024); } while (0)
#define PG8_MMA(ai, bj, At, Bt) do { __builtin_amdgcn_s_setprio(1); _Pragma("unroll") for (int m = 0; m < 4; ++m) _Pragma("unroll") for (int n = 0; n < 2; ++n) _Pragma("unroll") for (int k = 0; k < 2; ++k) \
        acc[ai][bj][m][n] = __builtin_amdgcn_mfma_f32_16x16x32_bf16(Bt[n][k], At[m][k], acc[ai][bj][m][n], 0, 0, 0); __builtin_amdgcn_s_setprio(0); } while (0)
#define PG8_WAIT_V(n) asm volatile("s_waitcnt vmcnt(" #n ")" ::: "memory")
#define PG8_WAIT_L(n) asm volatile("s_waitcnt lgkmcnt(" #n ")" ::: "memory")
#define PG8_BAR __builtin_amdgcn_s_barrier()
#define PG8_SCHED __builtin_amdgcn_sched_barrier(0)
    Unit cur, nxt; int ui = 0;
    if (!S_.next(0, cur)) return;
    f32x4 acc[2][2][4][2];
#pragma unroll
    for (int a = 0; a < 2; ++a)
#pragma unroll
        for (int b = 0; b < 2; ++b)
#pragma unroll
            for (int m = 0; m < 4; ++m)
#pragma unroll
                for (int n = 0; n < 2; ++n) acc[a][b][m][n] = (f32x4){0.f, 0.f, 0.f, 0.f};
    bf16x8 At[4][2], B0[2][2], B1[2][2];
    const char* cA = (const char*)g.A + (size_t)cur.pm * tstep; const char* cB = (const char*)g.Bt + (size_t)cur.pn * tstep;
    PG8_STAGE(PG8_SB(0, 0), cB, voffB0); PG8_STAGE(PG8_SB(0, 1), cB, voffB1); PG8_STAGE(PG8_SA(0, 0), cA, voffA); PG8_STAGE(PG8_SA(0, 1), cA + hstep, voffA);
    if (wr == 1) PG8_BAR;
    PG8_WAIT_V(2); PG8_BAR;
    PG8_STAGE(PG8_SB(1, 0), cB + kstep, voffB0); PG8_STAGE(PG8_SA(1, 0), cA + kstep, voffA); PG8_STAGE(PG8_SB(1, 1), cB + kstep, voffB1);
    PG8_WAIT_V(6); PG8_BAR;
    for (;;) {
        const bool has_next = S_.next(ui + 1, nxt);
        const char* nA = has_next ? (const char*)g.A + (size_t)nxt.pm * tstep : cA; const char* nB = has_next ? (const char*)g.Bt + (size_t)nxt.pn * tstep : cB;
        for (int t = 0; t < nt; t += 2) {
            const bool last = (t == nt - 2);
            const char* a1 = cA + (size_t)(t + 1) * kstep;
            const char* a2 = last ? nA : cA + (size_t)(t + 2) * kstep; const char* b2 = last ? nB : cB + (size_t)(t + 2) * kstep;
            const char* a3 = a2 + kstep; const char* b3 = b2 + kstep;
            PG8_LDB(B0, 0, 0); PG8_LDB(B1, 0, 1); PG8_SCHED; PG8_LDA(At, 0, 0); PG8_STAGE(PG8_SA(1, 1), a1 + hstep, voffA);
            PG8_WAIT_V(8); PG8_WAIT_L(0); PG8_BAR; PG8_MMA(0, 0, At, B0); PG8_MMA(0, 1, At, B1); PG8_BAR; PG8_SCHED;
            PG8_LDA(At, 0, 1); PG8_STAGE(PG8_SB(0, 0), b2, voffB0); PG8_STAGE(PG8_SB(0, 1), b2, voffB1); PG8_STAGE(PG8_SA(0, 0), a2, voffA);
            PG8_WAIT_V(8); PG8_WAIT_L(0); PG8_BAR; PG8_MMA(1, 0, At, B0); PG8_MMA(1, 1, At, B1); PG8_BAR; PG8_SCHED;
            PG8_LDB(B0, 1, 0); PG8_LDB(B1, 1, 1); PG8_SCHED; PG8_LDA(At, 1, 0); PG8_STAGE(PG8_SA(0, 1), a2 + hstep, voffA);
            PG8_WAIT_V(8); PG8_WAIT_L(0); PG8_BAR; PG8_MMA(0, 0, At, B0); PG8_MMA(0, 1, At, B1); PG8_BAR; PG8_SCHED;
            PG8_LDA(At, 1, 1); PG8_STAGE(PG8_SB(1, 0), b3, voffB0); PG8_STAGE(PG8_SB(1, 1), b3, voffB1); PG8_STAGE(PG8_SA(1, 0), a3, voffA);
            PG8_WAIT_V(8); PG8_WAIT_L(0); PG8_BAR; PG8_MMA(1, 0, At, B0); PG8_MMA(1, 1, At, B1); PG8_BAR; PG8_SCHED;
        }
        if (wr == 0) PG8_BAR;
        E(acc, cur, wr, wc, fr, fq);
        if (!has_next) break;
#pragma unroll
        for (int a = 0; a < 2; ++a)
#pragma unroll
            for (int b = 0; b < 2; ++b)
#pragma unroll
                for (int m = 0; m < 4; ++m)
#pragma unroll
                    for (int n = 0; n < 2; ++n) acc[a][b][m][n] = (f32x4){0.f, 0.f, 0.f, 0.f};
        cur = nxt; cA = nA; cB = nB; ++ui;
        if (wr == 1) PG8_BAR;
    }
    PG8_WAIT_V(0);
    PG8_BAR;
#undef PG8_SA
#undef PG8_SB
#undef PG8_STAGE
#undef PG8_LDA
#undef PG8_LDB
#undef PG8_MMA
#undef PG8_WAIT_V
#undef PG8_WAIT_L
#undef PG8_BAR
#undef PG8_SCHED
}
}

constexpr int KBUF = 16384, VBUF = 16384;
constexpr int LOFF_K = 0, LOFF_V = 4 * KBUF, LOFF_Q = 0  , LOFF_RPB = 131072;

__device__ __forceinline__ float max3f(float a, float b, float c) { float r; asm("v_max3_f32 %0, %1, %2, %3" : "=v"(r) : "v"(a), "v"(b), "v"(c)); return r; }
__device__ __forceinline__ float max2f(float a, float b) { float r; asm("v_max_f32_e32 %0, %1, %2" : "=v"(r) : "v"(a), "v"(b)); return r; }
__device__ __forceinline__ float rowmax32(const f32x16& a, const f32x16& b) {
    float m0 = max3f(a[0], a[1], a[2]), m1 = max3f(b[0], b[1], b[2]);
#pragma unroll
    for (int r = 3; r < 15; r += 2) { m0 = max3f(m0, a[r], a[r + 1]); m1 = max3f(m1, b[r], b[r + 1]); }
    float m = max3f(m0, m1, a[15]); m = max2f(m, b[15]);
    auto rr = __builtin_amdgcn_permlane32_swap(__float_as_uint(m), __float_as_uint(m), false, false);
    return max2f(__uint_as_float(rr[0]), __uint_as_float(rr[1]));
}

template <int TYPE>
__device__ __forceinline__ void attn_unit(const KParams& P, const int u, LAS unsigned char* lds, const float lam, const int tid) {
    constexpr bool CS = (TYPE == 1);
    constexpr int ND = CS ? 4 : 8;
    const int lane = tid & 63, wave = __builtin_amdgcn_readfirstlane(tid >> 6), i32 = lane & 31, kh = lane >> 5;
    const int comp = CS ? (wave & 1) : 0, qblk = CS ? (wave >> 1) : wave;
    unsigned char* ws = P.ws; unsigned char* ob = (unsigned char*)P.out;
    const bf16_t* proj = (const bf16_t*)(ws + WS_PROJ);
    const bf16_t *Qp, *Kp, *Vtp; size_t rs; int ql0, ks0, nt, half = 0, h;
    int a_r0 = 0, a_Rfirst = 0;
    int c_g = 0, c_dil = 1, c_c = 0;
    if constexpr (TYPE == 0) {
        h = u & 7; const int rg = u >> 3; a_r0 = 4 * rg;
        Qp = proj + h * 128; Kp = proj + 1024 + h * 128; Vtp = (const bf16_t*)(ws + WS_VT0) + (size_t)(h * 128) * S; rs = LD0; ql0 = a_r0 * 64;
        int rf = a_r0 - 4; rf = rf < 0 ? 0 : (rf > 248 ? 248 : rf);
        int rl = a_r0 + 3 - 4; rl = rl < 0 ? 0 : (rl > 248 ? 248 : rl); rl += 7;
        a_Rfirst = rf; ks0 = rf * 64; nt = rl - rf + 1;
    } else if constexpr (TYPE == 1) {
        h = u & 7; const int qb = u >> 3;
        Qp = proj + 3072 + h * 128; Kp = proj + 4096 + h * 128; Vtp = (const bf16_t*)(ws + WS_VT0) + (size_t)(1024 + h * 128) * S; rs = LD0; ql0 = 128 * qb; ks0 = 0; nt = S / 64;
    } else if constexpr (TYPE == 2) {
        c_g = u >> 9; const int rem = u & 511; h = rem >> 6; const int j = rem & 63;
        c_dil = (c_g == 0) ? 1 : ((c_g == 1) ? 4 : 16); const int nb = 64 / c_dil; c_c = j / nb; const int lb = j % nb; const int L = S / c_dil;
        Qp = proj + (size_t)c_c * LD1 + c_g * 1024 + h * 128; Kp = proj + (size_t)c_c * LD1 + 3072 + c_g * 1024 + h * 128; rs = (size_t)c_dil * LD1;
        Vtp = (const bf16_t*)(ws + WS_VT1) + (size_t)(c_g * 1024 + h * 128) * S + (size_t)c_c * L;
        ql0 = 256 * lb; half = 64; ks0 = 256 * lb - 64; if (ks0 < 0) ks0 = 0; int e = 256 * lb + 256 + 64; if (e > L) e = L; nt = (e - ks0) / 64;
    } else {
        const int kvh = u & 1; const int qb = u >> 1; h = kvh * 4 + (wave >> 1);
        Qp = proj + 7168 + h * 128; Kp = proj + 8192 + kvh * 128; rs = LD1; Vtp = (const bf16_t*)(ws + WS_VT1) + (size_t)(3072 + kvh * 128) * S;
        ql0 = 64 * qb; half = 128; ks0 = 64 * qb - 128; if (ks0 < 0) ks0 = 0; int e = 64 * qb + 64 + 128; if (e > S) e = S; nt = (e - ks0) / 64;
    }
    const int wq0 = ql0 + ((TYPE == 3) ? (wave & 1) : qblk) * 32;
    const bf16_t *kg0, *kg1, *vg0, *vg1;
    {
        const int r0_ = 8 * wave + (lane >> 4), r1_ = r0_ + 4, p = lane & 15;
        kg0 = Kp + (size_t)(ks0 + r0_) * rs + ((p ^ (r0_ & 15)) * 8);
        kg1 = Kp + (size_t)(ks0 + r1_) * rs + ((p ^ (r1_ & 15)) * 8);
        const int d0_ = 16 * wave + (lane >> 3), d1_ = d0_ + 8, pv = lane & 7;
        vg0 = Vtp + (size_t)d0_ * S + ks0 + ((pv ^ ((d0_ >> 1) & 7)) * 8);
        vg1 = Vtp + (size_t)d1_ * S + ks0 + ((pv ^ ((d1_ >> 1) & 7)) * 8);
    }
    const size_t ktile = 64 * rs;
    const unsigned dmaw = (unsigned)wave * 2048u;
#define AT_DMA_K(t, b) do { \
        __builtin_amdgcn_global_load_lds((const unsigned*)(kg0 + (size_t)(t) * ktile), (LAS unsigned*)(lds + LOFF_K + (b) * KBUF + dmaw), 16, 0, 0); \
        __builtin_amdgcn_global_load_lds((const unsigned*)(kg1 + (size_t)(t) * ktile), (LAS unsigned*)(lds + LOFF_K + (b) * KBUF + dmaw + 1024), 16, 0, 0); } while (0)
#define AT_DMA_V(t, b) do { \
        __builtin_amdgcn_global_load_lds((const unsigned*)(vg0 + (size_t)(t) * 64), (LAS unsigned*)(lds + LOFF_V + (b) * VBUF + dmaw), 16, 0, 0); \
        __builtin_amdgcn_global_load_lds((const unsigned*)(vg1 + (size_t)(t) * 64), (LAS unsigned*)(lds + LOFF_V + (b) * VBUF + dmaw + 1024), 16, 0, 0); } while (0)
#define AT_DMA(t, b) do { AT_DMA_K(t, b); AT_DMA_V(t, b); } while (0)
    AT_DMA(0, 0);
    if constexpr (CS) { AT_DMA(1, 1); AT_DMA_K(2, 2); }
    else { if (nt > 1) AT_DMA(1, 1); if (nt > 2) AT_DMA(2, 2); }
    bf16x8 qf[ND];
    {
        const bf16_t* qrow = Qp + (size_t)(wq0 + i32) * rs + comp * 64 + kh * 8;
#pragma unroll
        for (int d0 = 0; d0 < ND; ++d0) qf[d0] = *(const bf16x8*)(qrow + d0 * 16);
    }
    LAS float* rpbs = (LAS float*)(lds + LOFF_RPB);
    if constexpr (TYPE == 0) { const float* rpb = P.in[3] + h * 465; for (int idx = tid; idx < 465; idx += 512) rpbs[idx] = rpb[idx] * LOG2E; }
    f32x16 O[4];
#pragma unroll
    for (int d = 0; d < 4; ++d)
#pragma unroll
        for (int r = 0; r < 16; ++r) O[d][r] = 0.f;
    f32x16 negm;
#pragma unroll
    for (int r = 0; r < 16; ++r) negm[r] = 0.f;
    float mrun = 0.f, lrun = 0.f;
    bool first = true;
    const int i32_ = i32;
    asm volatile("s_waitcnt vmcnt(0) lgkmcnt(0)" ::: "memory");
    __syncthreads();
    if constexpr (CS) {
        const int pi = (i32 & 0x13) | ((i32 & 4) << 1) | ((i32 & 8) >> 1);
        const int xk16 = (((pi & 15) ^ kh) * 16) ^ (comp * 128), xv16 = (((i32 >> 1) & 7) ^ kh) * 16;
        const LAS unsigned char* Kb0 = lds + LOFF_K + pi * 256;
        const LAS unsigned char* Vb0 = lds + LOFF_V + i32 * 128;
        bf16x8 kf[8];
#pragma unroll
        for (int d0 = 0; d0 < 4; ++d0) { kf[2 * d0] = *(const LAS bf16x8*)(Kb0 + ((32 * d0) ^ xk16)); kf[2 * d0 + 1] = *(const LAS bf16x8*)(Kb0 + 8192 + ((32 * d0) ^ xk16)); }
        asm volatile("s_waitcnt lgkmcnt(0)" ::: "memory");
        __syncthreads();
        int b0 = 0, b1 = 1, b2 = 2;
        {
            float qs = 0.f;
#pragma unroll
            for (int d0 = 0; d0 < 4; ++d0)
#pragma unroll
                for (int j = 0; j < 8; ++j) qs += fabsf(bf2f((unsigned short)qf[d0][j]));
            qs = xhalf_sum(qs);
            const float kmx = __uint_as_float(((const unsigned*)(ob + DO_LSE))[h * 2 + comp]);
            mrun = fminf(qs * kmx * 1.01f, 100.f);
#pragma unroll
            for (int r = 0; r < 16; ++r) negm[r] = -mrun;
        }
        for (int t = 0; t < nt; ++t) {
            if (t + 3 < nt) AT_DMA_K(t + 3, b0);
            if (t + 2 < nt) AT_DMA_V(t + 2, b2);
            const LAS unsigned char* Vb = Vb0 + b0 * VBUF;
            f32x16 s0, s1;
            s0 = __builtin_amdgcn_mfma_f32_32x32x16_bf16(kf[0], qf[0], negm, 0, 0, 0); s1 = __builtin_amdgcn_mfma_f32_32x32x16_bf16(kf[1], qf[0], negm, 0, 0, 0);
#pragma unroll
            for (int d0 = 1; d0 < 4; ++d0) { s0 = __builtin_amdgcn_mfma_f32_32x32x16_bf16(kf[2 * d0], qf[d0], s0, 0, 0, 0); s1 = __builtin_amdgcn_mfma_f32_32x32x16_bf16(kf[2 * d0 + 1], qf[d0], s1, 0, 0, 0); }
            bf16x8 vfa[8], vfb[8];
#pragma unroll
            for (int i = 0; i < 8; ++i) vfa[i] = *(const LAS bf16x8*)(Vb + (i >> 2) * 4096 + ((32 * (i & 3)) ^ xv16));
            __builtin_amdgcn_sched_barrier(0);
            float sa = 0.f, sb_ = 0.f;
#pragma unroll
            for (int r = 0; r < 16; ++r) { s0[r] = __builtin_amdgcn_exp2f(s0[r]); s1[r] = __builtin_amdgcn_exp2f(s1[r]); sa += s0[r]; sb_ += s1[r]; }
            lrun += sa + sb_;
            bf16x8 pb[4];
            {
                u32x4 w0, w1, w2, w3;
                w0.x = cvtpk(s0[0], s0[1]); w0.y = cvtpk(s0[2], s0[3]); w0.z = cvtpk(s0[4], s0[5]); w0.w = cvtpk(s0[6], s0[7]);
                w1.x = cvtpk(s0[8], s0[9]); w1.y = cvtpk(s0[10], s0[11]); w1.z = cvtpk(s0[12], s0[13]); w1.w = cvtpk(s0[14], s0[15]);
                w2.x = cvtpk(s1[0], s1[1]); w2.y = cvtpk(s1[2], s1[3]); w2.z = cvtpk(s1[4], s1[5]); w2.w = cvtpk(s1[6], s1[7]);
                w3.x = cvtpk(s1[8], s1[9]); w3.y = cvtpk(s1[10], s1[11]); w3.z = cvtpk(s1[12], s1[13]); w3.w = cvtpk(s1[14], s1[15]);
                pb[0] = __builtin_bit_cast(bf16x8, w0); pb[1] = __builtin_bit_cast(bf16x8, w1); pb[2] = __builtin_bit_cast(bf16x8, w2); pb[3] = __builtin_bit_cast(bf16x8, w3);
            }
            __builtin_amdgcn_sched_barrier(0);
#pragma unroll
            for (int i = 0; i < 8; ++i) vfb[i] = *(const LAS bf16x8*)(Vb + (2 + (i >> 2)) * 4096 + ((32 * (i & 3)) ^ xv16));
#pragma unroll
            for (int i = 0; i < 8; ++i) O[i >> 2] = __builtin_amdgcn_mfma_f32_32x32x16_bf16(vfa[i], pb[i & 3], O[i >> 2], 0, 0, 0);
            __builtin_amdgcn_sched_barrier(0);
            if (t + 1 < nt) {
                const LAS unsigned char* Kn = Kb0 + b1 * KBUF;
#pragma unroll
                for (int d0 = 0; d0 < 4; ++d0) { kf[2 * d0] = *(const LAS bf16x8*)(Kn + ((32 * d0) ^ xk16)); kf[2 * d0 + 1] = *(const LAS bf16x8*)(Kn + 8192 + ((32 * d0) ^ xk16)); }
            }
#pragma unroll
            for (int i = 0; i < 8; ++i) O[2 + (i >> 2)] = __builtin_amdgcn_mfma_f32_32x32x16_bf16(vfb[i], pb[i & 3], O[2 + (i >> 2)], 0, 0, 0);
            if (t + 3 < nt) asm volatile("s_waitcnt vmcnt(4) lgkmcnt(0)" ::: "memory");
            else if (t + 2 < nt) asm volatile("s_waitcnt vmcnt(2) lgkmcnt(0)" ::: "memory");
            else asm volatile("s_waitcnt vmcnt(0) lgkmcnt(0)" ::: "memory");
            __builtin_amdgcn_s_barrier();
            asm volatile("" ::: "memory");
            { const int tmp = b0; b0 = b1; b1 = b2; b2 = tmp; }
        }
    } else
    for (int t = 0; t < nt; ++t) {
        const int b = t & 3;
        if (t + 3 < nt) AT_DMA(t + 3, (t + 3) & 3);
        const int ks = ks0 + 64 * t;
        bool skip = false;
        int a_dr = 0;
        if constexpr (TYPE == 0) { const int rq = a_r0 + (wave >> 1); int rsq = rq - 4; rsq = rsq < 0 ? 0 : (rsq > 248 ? 248 : rsq); const int R = a_Rfirst + t; skip = (R < rsq) || (R >= rsq + 8); a_dr = R - rq + 7; }
        if constexpr (TYPE >= 2) { skip = (ks > wq0 + 31 + half) || (ks + 63 < wq0 - half); }
        if (!skip) {
            int i32 = i32_; asm volatile("" : "+v"(i32));
            const int pi = (i32 & 0x13) | ((i32 & 4) << 1) | ((i32 & 8) >> 1);
            const int xk16 = (((pi & 15) ^ kh) * 16) ^ (comp * 128), xv16 = (((i32 >> 1) & 7) ^ kh) * 16;
            const LAS unsigned char* Kb = lds + LOFF_K + b * KBUF + pi * 256;
            const LAS unsigned char* Vb = lds + LOFF_V + b * VBUF + i32 * 128;
            f32x16 s0, s1;
#pragma unroll
            for (int d0 = 0; d0 < ND; ++d0) {
                const bf16x8 k0 = *(const LAS bf16x8*)(Kb + ((32 * d0) ^ xk16));
                const bf16x8 k1 = *(const LAS bf16x8*)(Kb + 8192 + ((32 * d0) ^ xk16));
                if (d0 == 0) {
                    if constexpr (CS) { s0 = __builtin_amdgcn_mfma_f32_32x32x16_bf16(k0, qf[0], negm, 0, 0, 0); s1 = __builtin_amdgcn_mfma_f32_32x32x16_bf16(k1, qf[0], negm, 0, 0, 0); }
                    else { const float ng = -mrun;
#pragma unroll
                        for (int r = 0; r < 16; ++r) { s0[r] = ng; s1[r] = ng; }
                        s0 = __builtin_amdgcn_mfma_f32_32x32x16_bf16(k0, qf[0], s0, 0, 0, 0); s1 = __builtin_amdgcn_mfma_f32_32x32x16_bf16(k1, qf[0], s1, 0, 0, 0); }
                }
                else { s0 = __builtin_amdgcn_mfma_f32_32x32x16_bf16(k0, qf[d0], s0, 0, 0, 0); s1 = __builtin_amdgcn_mfma_f32_32x32x16_bf16(k1, qf[d0], s1, 0, 0, 0); }
                if (d0 & 1) __builtin_amdgcn_sched_barrier(0);
            }
            if constexpr (TYPE == 0) {
                const int cq = 32 * (wave & 1) + i32; int cs_ = cq - 8; cs_ = cs_ < 0 ? 0 : (cs_ > 48 ? 48 : cs_);
                int vb = 8 * kh - cs_; asm volatile("" : "+v"(vb));
                int ib = a_dr * 31 + 8 * kh - cq + 15; asm volatile("" : "+v"(ib));
                const LAS float* rp = rpbs + ib;
#pragma unroll
                for (int r = 0; r < 16; ++r) {
                    const int C0 = 16 * (r >> 3) + (r & 7), C1 = C0 + 32;
                    const float b0 = rp[C0], b1 = rp[C1];
                    s0[r] = ((unsigned)(vb + C0) < 16u) ? (s0[r] + b0) : -INFINITY;
                    s1[r] = ((unsigned)(vb + C1) < 16u) ? (s1[r] + b1) : -INFINITY;
                    if ((r & 3) == 3) __builtin_amdgcn_sched_barrier(0);
                }
            }
            if constexpr (TYPE >= 2) {
                const int base = ks + 8 * kh - (wq0 + i32) + half; const unsigned lim = 2u * (unsigned)half;
#pragma unroll
                for (int r = 0; r < 16; ++r) {
                    const int o0 = 16 * (r >> 3) + (r & 7);
                    if ((unsigned)(base + o0) > lim) s0[r] = -INFINITY;
                    if ((unsigned)(base + o0 + 32) > lim) s1[r] = -INFINITY;
                }
            }
            asm volatile("s_nop 15\n\ts_nop 7" : "+v"(s0), "+v"(s1));
            const float delta = rowmax32(s0, s1);
            if (first) {
                const float dl = (delta > -1e30f) ? delta : 0.f;
                mrun += dl;
#pragma unroll
                for (int r = 0; r < 16; ++r) { s0[r] -= dl; s1[r] -= dl; }
                if constexpr (CS) {
#pragma unroll
                    for (int r = 0; r < 16; ++r) negm[r] = -mrun; }
            } else if (__any(delta > 6.0f)) {
                const float dl = fmaxf(delta, 0.f);
                mrun += dl;
                const float f = __builtin_amdgcn_exp2f(-dl);
                lrun *= f;
#pragma unroll
                for (int r = 0; r < 16; ++r) { s0[r] -= dl; s1[r] -= dl; }
#pragma unroll
                for (int d = 0; d < 4; ++d)
#pragma unroll
                    for (int r = 0; r < 16; ++r) O[d][r] *= f;
                if constexpr (CS) {
#pragma unroll
                    for (int r = 0; r < 16; ++r) negm[r] = -mrun; }
            }
            first = false;
            float sa = 0.f, sb_ = 0.f;
#pragma unroll
            for (int r = 0; r < 16; ++r) { s0[r] = __builtin_amdgcn_exp2f(s0[r]); s1[r] = __builtin_amdgcn_exp2f(s1[r]); sa += s0[r]; sb_ += s1[r]; }
            lrun += sa + sb_;
            bf16x8 pb[4];
            {
                u32x4 w0, w1, w2, w3;
                w0.x = cvtpk(s0[0], s0[1]); w0.y = cvtpk(s0[2], s0[3]); w0.z = cvtpk(s0[4], s0[5]); w0.w = cvtpk(s0[6], s0[7]);
                w1.x = cvtpk(s0[8], s0[9]); w1.y = cvtpk(s0[10], s0[11]); w1.z = cvtpk(s0[12], s0[13]); w1.w = cvtpk(s0[14], s0[15]);
                w2.x = cvtpk(s1[0], s1[1]); w2.y = cvtpk(s1[2], s1[3]); w2.z = cvtpk(s1[4], s1[5]); w2.w = cvtpk(s1[6], s1[7]);
                w3.x = cvtpk(s1[8], s1[9]); w3.y = cvtpk(s1[10], s1[11]); w3.z = cvtpk(s1[12], s1[13]); w3.w = cvtpk(s1[14], s1[15]);
                pb[0] = __builtin_bit_cast(bf16x8, w0); pb[1] = __builtin_bit_cast(bf16x8, w1); pb[2] = __builtin_bit_cast(bf16x8, w2); pb[3] = __builtin_bit_cast(bf16x8, w3);
            }
            __builtin_amdgcn_sched_barrier(0);
#pragma unroll
            for (int dblk = 0; dblk < 4; ++dblk) {
#pragma unroll
                for (int kc = 0; kc < 4; ++kc) {
                    const bf16x8 vf = *(const LAS bf16x8*)(Vb + dblk * 4096 + ((32 * kc) ^ xv16));
                    O[dblk] = __builtin_amdgcn_mfma_f32_32x32x16_bf16(vf, pb[kc], O[dblk], 0, 0, 0);
                }
                if (dblk & 1) __builtin_amdgcn_sched_barrier(0);
            }
        }
        if (t + 3 < nt) asm volatile("s_waitcnt vmcnt(8) lgkmcnt(0)" ::: "memory");
        else if (t + 2 < nt) asm volatile("s_waitcnt vmcnt(4) lgkmcnt(0)" ::: "memory");
        else asm volatile("s_waitcnt vmcnt(0) lgkmcnt(0)" ::: "memory");
        __builtin_amdgcn_s_barrier();
        asm volatile("" ::: "memory");
    }
#undef AT_DMA
#undef AT_DMA_K
#undef AT_DMA_V
    const float lt = lrun + __shfl_xor(lrun, 32);
    const int tq = wq0 + i32;
    if constexpr (TYPE == 0) {
        const float il = 1.0f / lt;
        const bf16_t* grow = proj + (size_t)tq * LD0 + 2048 + h * 128 + 4 * kh;
        bf16_t* orow = (bf16_t*)(ob + DO_MIX) + (size_t)tq * DM + h * 128 + 4 * kh;
#pragma unroll
        for (int dblk = 0; dblk < 4; ++dblk)
#pragma unroll
            for (int g4 = 0; g4 < 4; ++g4) {
                const u32x2 gw = *(const u32x2*)(grow + dblk * 32 + g4 * 8);
                const float o0 = O[dblk][4 * g4 + 0] * il * silu_f(bflo(gw.x)), o1 = O[dblk][4 * g4 + 1] * il * silu_f(bfhi(gw.x));
                const float o2 = O[dblk][4 * g4 + 2] * il * silu_f(bflo(gw.y)), o3 = O[dblk][4 * g4 + 3] * il * silu_f(bfhi(gw.y));
                u32x2 w; w.x = cvtpk(o0, o1); w.y = cvtpk(o2, o3);
                *(u32x2*)(orow + dblk * 32 + g4 * 8) = w;
                if (g4 & 1) __builtin_amdgcn_sched_barrier(0);
            }
    } else if constexpr (TYPE == 1) {
        LAS float* X = (LAS float*)(lds + LOFF_Q) + (size_t)(qblk * 32 + i32) * 132 + 4 * kh;
        if (comp == 1) {
            const float f1 = lam / lt;
#pragma unroll
            for (int dblk = 0; dblk < 4; ++dblk)
#pragma unroll
                for (int g4 = 0; g4 < 4; ++g4)
                    *(LAS f32x4*)(X + dblk * 32 + g4 * 8) = (f32x4){O[dblk][4 * g4 + 0] * f1, O[dblk][4 * g4 + 1] * f1, O[dblk][4 * g4 + 2] * f1, O[dblk][4 * g4 + 3] * f1};
        }
        __syncthreads();
        if (comp == 0) {
            const float il0 = 1.0f / lt;
            float ss = 0.f;
#pragma unroll
            for (int dblk = 0; dblk < 4; ++dblk)
#pragma unroll
                for (int g4 = 0; g4 < 4; ++g4) {
                    const f32x4 x1 = *(const LAS f32x4*)(X + dblk * 32 + g4 * 8);
#pragma unroll
                    for (int j = 0; j < 4; ++j) { const float o = O[dblk][4 * g4 + j] * il0 - x1[j]; O[dblk][4 * g4 + j] = o; ss += o * o; }
                }
            ss += __shfl_xor(ss, 32);
            const float rn = rsqrtf(ss * (1.0f / 128.0f) + 1e-6f) * 0.8f;
            const bf16_t* grow = proj + (size_t)tq * LD0 + 5120 + h * 128 + 4 * kh;
            bf16_t* orow = (bf16_t*)(ob + DO_MIX) + (size_t)tq * DM + 1024 + h * 128 + 4 * kh;
            const float* sg = P.in[8] + 4 * kh;
#pragma unroll
            for (int dblk = 0; dblk < 4; ++dblk)
#pragma unroll
                for (int g4 = 0; g4 < 4; ++g4) {
                    const u32x2 gw = *(const u32x2*)(grow + dblk * 32 + g4 * 8);
                    const f32x4 sv = *(const f32x4*)(sg + dblk * 32 + g4 * 8);
                    const float o0 = O[dblk][4 * g4 + 0] * rn * sv[0] * silu_f(bflo(gw.x)), o1 = O[dblk][4 * g4 + 1] * rn * sv[1] * silu_f(bfhi(gw.x));
                    const float o2 = O[dblk][4 * g4 + 2] * rn * sv[2] * silu_f(bflo(gw.y)), o3 = O[dblk][4 * g4 + 3] * rn * sv[3] * silu_f(bfhi(gw.y));
                    u32x2 w; w.x = cvtpk(o0, o1); w.y = cvtpk(o2, o3);
                    *(u32x2*)(orow + dblk * 32 + g4 * 8) = w;
                    if (g4 & 1) __builtin_amdgcn_sched_barrier(0);
                }
        }
        __syncthreads();
    } else if constexpr (TYPE == 2) {
        const float il = 1.0f / lt;
        const size_t tok = (size_t)tq * c_dil + c_c;
        bf16_t* orow = (bf16_t*)proj + tok * LD1 + c_g * 1024 + h * 128 + 4 * kh;
#pragma unroll
        for (int dblk = 0; dblk < 4; ++dblk)
#pragma unroll
            for (int g4 = 0; g4 < 4; ++g4) {
                u32x2 w; w.x = cvtpk(O[dblk][4 * g4 + 0] * il, O[dblk][4 * g4 + 1] * il); w.y = cvtpk(O[dblk][4 * g4 + 2] * il, O[dblk][4 * g4 + 3] * il);
                *(u32x2*)(orow + dblk * 32 + g4 * 8) = w;
                if (g4 & 1) __builtin_amdgcn_sched_barrier(0);
            }
        if (kh == 0) ((float*)(ob + DO_LSE))[tok * 24 + c_g * 8 + h] = mrun + __builtin_amdgcn_logf(lt);
    } else {
        const float sk = P.in[13][h] * LOG2E;
        const float il = 1.0f / (lt + __builtin_amdgcn_exp2f(sk - mrun));
        const bf16_t* grow = proj + (size_t)tq * LD1 + 8448 + h * 128 + 4 * kh;
        bf16_t* orow = (bf16_t*)(ob + DO_MIX) + (size_t)tq * DM + 1024 + h * 128 + 4 * kh;
#pragma unroll
        for (int dblk = 0; dblk < 4; ++dblk)
#pragma unroll
            for (int g4 = 0; g4 < 4; ++g4) {
                const u32x2 gw = *(const u32x2*)(grow + dblk * 32 + g4 * 8);
                const float o0 = O[dblk][4 * g4 + 0] * il * silu_f(bflo(gw.x)), o1 = O[dblk][4 * g4 + 1] * il * silu_f(bfhi(gw.x));
                const float o2 = O[dblk][4 * g4 + 2] * il * silu_f(bflo(gw.y)), o3 = O[dblk][4 * g4 + 3] * il * silu_f(bfhi(gw.y));
                u32x2 w; w.x = cvtpk(o0, o1); w.y = cvtpk(o2, o3);
                *(u32x2*)(orow + dblk * 32 + g4 * 8) = w;
                if (g4 & 1) __builtin_amdgcn_sched_barrier(0);
            }
    }
}

__device__ __forceinline__ void transpose_item(const float* W, int ldw, int c0, int nc, bf16_t* dst, int r0, LAS float* scr, int item, int lane) {
    const int nblk = nc / 32, kb = item / nblk, nb = item % nblk, k0 = 64 * kb, n0 = 32 * nb;
#pragma unroll 8
    for (int i = 0; i < 32; ++i) { const int kk = 2 * i + (lane >> 5); scr[kk * 33 + (lane & 31)] = W[(size_t)(k0 + kk) * ldw + c0 + n0 + (lane & 31)]; }
    asm volatile("s_waitcnt lgkmcnt(0)" ::: "memory");
    const int c = lane & 7;
#pragma unroll
    for (int j = 0; j < 4; ++j) { const int n = (lane >> 3) + 8 * j; const LAS float* s = scr + (8 * c) * 33 + n;
        u32x4 o; o.x = cvtpk(s[0 * 33], s[1 * 33]); o.y = cvtpk(s[2 * 33], s[3 * 33]); o.z = cvtpk(s[4 * 33], s[5 * 33]); o.w = cvtpk(s[6 * 33], s[7 * 33]);
        *(u32x4*)(dst + (size_t)(r0 + n0 + n) * DM + k0 + 8 * c) = o; }
    asm volatile("s_waitcnt lgkmcnt(0)" ::: "memory");
}
__device__ __forceinline__ void sincos_d(float ang, float& c, float& s) {
    const double a = (double)ang;
    const double k = __builtin_rint(a * 0.15915494309189535);
    const double r = __builtin_fma(-k, 6.283185307179586, a) - k * 2.4492935982947064e-16;
    const double r2 = r * r;
    double sp = -1.0 / 51090942171709440000.0;
    sp = sp * r2 + 1.0 / 121645100408832000.0;
    sp = sp * r2 - 1.0 / 355687428096000.0;
    sp = sp * r2 + 1.0 / 1307674368000.0;
    sp = sp * r2 - 1.0 / 6227020800.0;
    sp = sp * r2 + 1.0 / 39916800.0;
    sp = sp * r2 - 1.0 / 362880.0;
    sp = sp * r2 + 1.0 / 5040.0;
    sp = sp * r2 - 1.0 / 120.0;
    sp = sp * r2 + 1.0 / 6.0;
    sp = sp * r2 - 1.0;
    s = (float)(-(sp * r));
    double cp = 1.0 / 1124000727777607680000.0;
    cp = cp * r2 - 1.0 / 2432902008176640000.0;
    cp = cp * r2 + 1.0 / 6402373705728000.0;
    cp = cp * r2 - 1.0 / 20922789888000.0;
    cp = cp * r2 + 1.0 / 87178291200.0;
    cp = cp * r2 - 1.0 / 479001600.0;
    cp = cp * r2 + 1.0 / 3628800.0;
    cp = cp * r2 - 1.0 / 40320.0;
    cp = cp * r2 + 1.0 / 720.0;
    cp = cp * r2 - 1.0 / 24.0;
    cp = cp * r2 + 0.5;
    c = (float)(1.0 - cp * r2);
}
__device__ __forceinline__ void rms_row_to_bf16(const float* xrow, const float* g, bf16_t* orow, int lane) {
    const f32x4* xr = (const f32x4*)xrow + lane; const f32x4* gr = (const f32x4*)g + lane;
    f32x4 v[8]; float s = 0.f;
#pragma unroll
    for (int j = 0; j < 8; ++j) { v[j] = xr[64 * j]; s += (v[j].x * v[j].x + v[j].y * v[j].y) + (v[j].z * v[j].z + v[j].w * v[j].w); }
    const float rstd = rsqrtf(wave_sum(s) * (1.f / DM) + 1e-6f);
    u32x2* o8 = (u32x2*)orow + lane;
#pragma unroll
    for (int j = 0; j < 8; ++j) { const f32x4 gg = gr[64 * j]; u32x2 w; w.x = cvtpk(v[j].x * rstd * gg.x, v[j].y * rstd * gg.y); w.y = cvtpk(v[j].z * rstd * gg.z, v[j].w * rstd * gg.w); o8[64 * j] = w; }
}

__device__ unsigned g_bar_word[64];
__device__ __forceinline__ void grid_bar_fast(const unsigned G) {
    asm volatile("s_waitcnt vmcnt(0) lgkmcnt(0)" ::: "memory");
    __syncthreads();
    if (threadIdx.x == 0) {
        __builtin_amdgcn_fence(__ATOMIC_RELEASE, "agent");
        asm volatile("s_waitcnt vmcnt(0)" ::: "memory");
        const unsigned old = __hip_atomic_fetch_add(&g_bar_word[0], 1u, __ATOMIC_RELAXED, __HIP_MEMORY_SCOPE_AGENT);
        const unsigned target = (old / G + 1u) * G;
        while ((int)(__hip_atomic_load(&g_bar_word[0], __ATOMIC_RELAXED, __HIP_MEMORY_SCOPE_AGENT) - target) < 0) __builtin_amdgcn_s_sleep(1);
        __builtin_amdgcn_fence(__ATOMIC_ACQUIRE, "agent");
        asm volatile("s_waitcnt vmcnt(0)" ::: "memory");
    }
    __syncthreads();
}

constexpr int LDS_BYTES = 147456;
constexpr int NPH = 11;

#define GETP(name) const KParams* name##_p = (const KParams*)__builtin_amdgcn_kernarg_segment_ptr(); asm volatile("" : "+s"(name##_p)); const KParams& name = *name##_p;
__global__ void __launch_bounds__(512, 2) fwd_kernel(Params Punused) {
#if defined(__HIP_DEVICE_COMPILE__)
    extern __shared__ __attribute__((aligned(16))) unsigned char lds_raw[];
    LAS unsigned char* lds = (LAS unsigned char*)lds_raw;
    cg::grid_group grid = cg::this_grid();
    const int wave = __builtin_amdgcn_readfirstlane(threadIdx.x >> 6);
#define MYTID(t_) int t_; asm volatile("v_mbcnt_lo_u32_b32 %0, -1, 0\n\tv_mbcnt_hi_u32_b32 %0, -1, %0" : "=v"(t_)); t_ += wave * 64
    const int G = gridDim.x, bx = blockIdx.x;
    const int gw = bx * 8 + wave, NGW = G * 8;
    int ph_lo, ph_hi; unsigned char* ws; unsigned char* ob;
    { GETP(PT); ph_lo = PT.ph_lo; ph_hi = PT.ph_hi; ws = PT.ws; ob = (unsigned char*)PT.out; }
#define IN(k) (ph_lo <= (k) && (k) < ph_hi)
#define SEAM(k) do { if (IN(k) && IN((k) + 1)) { if ((k) == 0) grid.sync(); else grid_bar_fast((unsigned)G); } } while (0)

    if (IN(0)) {
        GETP(P);
        MYTID(tid); const int lane = tid & 63;
        LAS float* scr = (LAS float*)(lds + wave * 16384);
        const float* Win0 = P.in[2]; const float* Wout0 = P.in[9]; const float* Win1 = P.in[12]; const float* Wout1 = P.in[14];
        bf16_t* Bt0 = (bf16_t*)(ws + WS_BT0); bf16_t* Wv0 = (bf16_t*)(ws + WS_WV0); bf16_t* Bo0 = (bf16_t*)(ws + WS_BO0); bf16_t* Bo1 = (bf16_t*)(ws + WS_BO1);
        bf16_t* Bt1 = (bf16_t*)(ob + DO_BT1); bf16_t* Wv1 = (bf16_t*)(ob + DO_WV1);
        constexpr int NIT = 8192 + 12800 + 2048 + 2048;
        for (int it = gw; it < NIT; it += NGW) {
            int r = it;
            if (r < 2048) { transpose_item(Win0, 8192, 0, 2048, Bt0, 0, scr, r, lane); continue; } r -= 2048;
            if (r < 3072) { transpose_item(Win0, 8192, 3072, 3072, Bt0, 2048, scr, r, lane); continue; } r -= 3072;
            if (r < 1024) { transpose_item(Win0, 8192, 7168, 1024, Bt0, 5120, scr, r, lane); continue; } r -= 1024;
            if (r < 1024) { transpose_item(Win0, 8192, 2048, 1024, Wv0, 0, scr, r, lane); continue; } r -= 1024;
            if (r < 1024) { transpose_item(Win0, 8192, 6144, 1024, Wv0, 1024, scr, r, lane); continue; } r -= 1024;
            if (r < 6144) { transpose_item(Win1, 12800, 0, 6144, Bt1, 0, scr, r, lane); continue; } r -= 6144;
            if (r < 2304) { transpose_item(Win1, 12800, 9216, 2304, Bt1, 6144, scr, r, lane); continue; } r -= 2304;
            if (r < 1024) { transpose_item(Win1, 12800, 11776, 1024, Bt1, 8448, scr, r, lane); continue; } r -= 1024;
            if (r < 3072) { transpose_item(Win1, 12800, 6144, 3072, Wv1, 0, scr, r, lane); continue; } r -= 3072;
            if (r < 256) { transpose_item(Win1, 12800, 11520, 256, Wv1, 3072, scr, r, lane); continue; } r -= 256;
            if (r < 2048) { transpose_item(Wout0, 2048, 0, 2048, Bo0, 0, scr, r, lane); continue; } r -= 2048;
            transpose_item(Wout1, 2048, 0, 2048, Bo1, 0, scr, r, lane);
        }
        for (int m = gw; m < S; m += NGW) rms_row_to_bf16(P.in[0] + (size_t)m * DM, P.in[1], (bf16_t*)(ws + WS_H0R0) + (size_t)m * DM, lane);
        if (bx == 0 && tid < 16) ((unsigned*)(ob + DO_LSE))[tid] = 0u;
        float* tab0 = (float*)(ob + DO_TAB0); float* tab1 = (float*)(ob + DO_TAB1);
        for (int idx = bx * 512 + tid; idx < S * 24; idx += G * 512) {
            if (idx < S * 8) { const int pos = idx >> 3, i = idx & 7; float c, s; sincos_d((float)pos * P.inv0[i], c, s); tab0[2 * idx] = c; tab0[2 * idx + 1] = s; }
            else { const int j = idx - S * 8; const int pos = j >> 4, i = j & 15; float c, s; sincos_d((float)pos * P.inv1[i], c, s); tab1[2 * j] = c; tab1[2 * j + 1] = s; }
        }
    }
    SEAM(0);

#pragma clang loop unroll(full)
    for (int layer = 0; layer < 2; ++layer) {
        const int pb = 1 + 5 * layer;
        if (IN(pb)) {
            const bf16_t* hA = layer == 0 ? (const bf16_t*)(ws + WS_H0R0) : (const bf16_t*)(ob + DO_MIX);
            {
                pg8::Gemm g{hA, layer == 0 ? (const bf16_t*)(ws + WS_BT0) : (const bf16_t*)(ob + DO_BT1), S, layer == 0 ? LD0 : LD1, DM, 1};
                pg8::StaticOrder so; so.init(g.M, g.N, G, bx);
                pg8::EpiMain E{(bf16_t*)(ws + WS_PROJ), g.N, layer == 0 ? (const float*)(ob + DO_TAB0) : (const float*)(ob + DO_TAB1), layer, (unsigned*)(ob + DO_LSE)};

#ifndef SKIP_GM
                { MYTID(t_); pg8::gemm_phase<pg8::EpiMain>(lds, g, so, E, t_); }
#endif

            }
            const int ncall = layer == 0 ? 1 : 4;
            for (int q = 0; q < ncall; ++q) {
                const bf16_t* Wv; bf16_t* Vt; int Mv, dil;
                if (layer == 0) { Wv = (const bf16_t*)(ws + WS_WV0); Vt = (bf16_t*)(ws + WS_VT0); Mv = 2048; dil = 1; }
                else if (q < 3) { Wv = (const bf16_t*)(ob + DO_WV1) + (size_t)q * 1024 * DM; Vt = (bf16_t*)(ws + WS_VT1) + (size_t)q * 1024 * S; Mv = 1024; dil = (q == 0) ? 1 : (q == 1 ? 4 : 16); }
                else { Wv = (const bf16_t*)(ob + DO_WV1) + (size_t)3072 * DM; Vt = (bf16_t*)(ws + WS_VT1) + (size_t)3072 * S; Mv = 256; dil = 1; }
                pg8::Gemm g{Wv, hA, Mv, S, DM, dil};
                pg8::StaticOrder so; so.init(g.M, g.N, G, (layer == 1 && q == 3 && G == 256) ? ((bx + 192) & 255) : bx);
                pg8::EpiVt E{Vt, dil};

#ifndef SKIP_GV
                { MYTID(t_); pg8::gemm_phase<pg8::EpiVt>(lds, g, so, E, t_); }
#endif

            }
        }
        SEAM(pb);
        if (IN(pb + 1)) {
            GETP(P);
            if (layer == 0) {
                float lam;
                { MYTID(tl_); const int lane = tl_ & 63; const float a = P.in[4][lane] * P.in[5][lane], b = P.in[6][lane] * P.in[7][lane];
                  lam = __expf(wave_sum(a)) - __expf(wave_sum(b)) + 0.2f; }
#ifndef SKIP_B
                for (int u = bx; u < 1024; u += G) { MYTID(t_); attn_unit<1>(P, u, lds, lam, t_); }
#endif
#ifndef SKIP_A
                for (int u = bx; u < 512; u += G) { MYTID(t_); attn_unit<0>(P, u, lds, 0.f, t_); }
#endif
            } else {
#ifndef SKIP_C
                for (int u = bx; u < 1536; u += G) { MYTID(t_); attn_unit<2>(P, u, lds, 0.f, t_); }
#endif
#ifndef SKIP_D
                for (int u = bx; u < 512; u += G) { MYTID(t_); attn_unit<3>(P, u, lds, 0.f, t_); }
#endif
            }
        }
        SEAM(pb + 1);
        if (IN(pb + 2) && layer == 1) {
            const bf16_t* proj = (const bf16_t*)(ws + WS_PROJ); const float* lse = (const float*)(ob + DO_LSE); bf16_t* mix = (bf16_t*)(ob + DO_MIX);
            MYTID(tm_);
            for (int it = bx * 512 + tm_; it < S * 128; it += G * 512) {
                const int t = it >> 7, hh = (it >> 4) & 7, ch = it & 15;
                const float l0 = lse[(size_t)t * 24 + hh], l1 = lse[(size_t)t * 24 + 8 + hh], l2 = lse[(size_t)t * 24 + 16 + hh];
                const float mx = fmaxf(l0, fmaxf(l1, l2));
                float w0 = __builtin_amdgcn_exp2f(l0 - mx), w1 = __builtin_amdgcn_exp2f(l1 - mx), w2 = __builtin_amdgcn_exp2f(l2 - mx);
                const float iw = 1.0f / (w0 + w1 + w2); w0 *= iw; w1 *= iw; w2 *= iw;
                const bf16_t* pr = proj + (size_t)t * LD1 + hh * 128 + ch * 8;
                const u32x4 a0 = *(const u32x4*)pr, a1 = *(const u32x4*)(pr + 1024), a2 = *(const u32x4*)(pr + 2048), gg = *(const u32x4*)(pr + 6144);
                u32x4 o;
#pragma unroll
                for (int k = 0; k < 4; ++k) {
                    const float lo = (w0 * bflo(a0[k]) + w1 * bflo(a1[k]) + w2 * bflo(a2[k])) * silu_f(bflo(gg[k]));
                    const float hi = (w0 * bfhi(a0[k]) + w1 * bfhi(a1[k]) + w2 * bfhi(a2[k])) * silu_f(bfhi(gg[k]));
                    o[k] = cvtpk(lo, hi);
                }
                *(u32x4*)(mix + (size_t)t * DM + hh * 128 + ch * 8) = o;
            }
        }
        if (layer == 1) SEAM(pb + 2);
        if (IN(pb + 3)) {
            pg8::Gemm g{(const bf16_t*)(ob + DO_MIX), layer == 0 ? (const bf16_t*)(ws + WS_BO0) : (const bf16_t*)(ws + WS_BO1), S, DM, DM, 1};
            pg8::StaticOrder so; so.init(g.M, g.N, G, bx);
            pg8::EpiF32 E{(bf16_t*)(ws + WS_PROJ), DM};

#ifndef SKIP_GF
                { MYTID(t_); pg8::gemm_phase<pg8::EpiF32>(lds, g, so, E, t_); }
#endif

        }
        SEAM(pb + 3);
        if (IN(pb + 4)) {
            GETP(P);
            const bf16_t* Y = (const bf16_t*)(ws + WS_PROJ); bf16_t* R0 = (bf16_t*)(ws + WS_H0R0);
            const float* gpost = layer == 0 ? P.in[10] : P.in[15];
            MYTID(tr_); const int lane = tr_ & 63;
            for (int m = gw; m < S; m += NGW) {
                const u32x2* yr = (const u32x2*)(Y + (size_t)m * DM) + lane; const f32x4* xr = (const f32x4*)(P.in[0] + (size_t)m * DM) + lane;
                const f32x4* gp = (const f32x4*)gpost + lane;
                f32x4 v[8]; float s = 0.f;
#pragma unroll
                for (int j = 0; j < 8; ++j) { const u32x2 yw = yr[64 * j]; v[j].x = bflo(yw.x); v[j].y = bfhi(yw.x); v[j].z = bflo(yw.y); v[j].w = bfhi(yw.y); s += (v[j].x * v[j].x + v[j].y * v[j].y) + (v[j].z * v[j].z + v[j].w * v[j].w); }
                const float rstd = rsqrtf(wave_sum(s) * (1.f / DM) + 1e-6f);
                if (layer == 0) {
                    u32x2* r8 = (u32x2*)(R0 + (size_t)m * DM) + lane; float s1 = 0.f;
#pragma unroll
                    for (int j = 0; j < 8; ++j) { const f32x4 gg = gp[64 * j]; const f32x4 xx = xr[64 * j];
                        u32x2 w; w.x = cvtpk(v[j].x * rstd * gg.x, v[j].y * rstd * gg.y); w.y = cvtpk(v[j].z * rstd * gg.z, v[j].w * rstd * gg.w); r8[64 * j] = w;
                        v[j].x = xx.x + bflo(w.x); v[j].y = xx.y + bfhi(w.x); v[j].z = xx.z + bflo(w.y); v[j].w = xx.w + bfhi(w.y);
                        s1 += (v[j].x * v[j].x + v[j].y * v[j].y) + (v[j].z * v[j].z + v[j].w * v[j].w); }
                    const float rstd1 = rsqrtf(wave_sum(s1) * (1.f / DM) + 1e-6f);
                    const f32x4* g1 = (const f32x4*)P.in[11] + lane; u32x2* h8 = (u32x2*)((bf16_t*)(ob + DO_MIX) + (size_t)m * DM) + lane;
#pragma unroll
                    for (int j = 0; j < 8; ++j) { const f32x4 gg = g1[64 * j]; u32x2 w; w.x = cvtpk(v[j].x * rstd1 * gg.x, v[j].y * rstd1 * gg.y); w.y = cvtpk(v[j].z * rstd1 * gg.z, v[j].w * rstd1 * gg.w); h8[64 * j] = w; }
                } else {
                    const u32x2* r8 = (const u32x2*)(R0 + (size_t)m * DM) + lane; f32x4* o4 = (f32x4*)(P.out + (size_t)m * DM) + lane;
#pragma unroll
                    for (int j = 0; j < 8; ++j) { const f32x4 gg = gp[64 * j]; const f32x4 xx = xr[64 * j]; const u32x2 w = r8[64 * j];
                        f32x4 o; o.x = xx.x + bflo(w.x) + v[j].x * rstd * gg.x; o.y = xx.y + bfhi(w.x) + v[j].y * rstd * gg.y; o.z = xx.z + bflo(w.y) + v[j].z * rstd * gg.z; o.w = xx.w + bfhi(w.y) + v[j].w * rstd * gg.w;
                        __builtin_nontemporal_store(o, o4 + 64 * j); }
                }
            }
        }
        if (layer == 0) SEAM(pb + 4);
    }
#undef IN
#undef SEAM
#endif
}

extern "C" void kernel_launch(void* const* d_in, const int* in_sizes, int n_in, void* d_out, int out_size, void* d_ws, size_t ws_size, hipStream_t stream) {
    static int grid = 0;
    if (grid == 0) {
        if (n_in != 16 || out_size != S * DM || ws_size < WS_NEED) { fprintf(stderr, "kernel_launch: unexpected shapes: n_in %d out %d ws %zu\n", n_in, out_size, ws_size); grid = -1; return; }
        int dev = 0, cus = 0, per_cu = 0;
        hipGetDevice(&dev);
        hipDeviceGetAttribute(&cus, hipDeviceAttributeMultiprocessorCount, dev);
        if (hipFuncSetAttribute((const void*)fwd_kernel, hipFuncAttributeMaxDynamicSharedMemorySize, LDS_BYTES) != hipSuccess) { fprintf(stderr, "kernel_launch: hipFuncSetAttribute failed\n"); grid = -1; return; }
        if (hipOccupancyMaxActiveBlocksPerMultiprocessor(&per_cu, (const void*)fwd_kernel, 512, LDS_BYTES) != hipSuccess || per_cu < 1) { fprintf(stderr, "kernel_launch: occupancy query says %d\n", per_cu); per_cu = 1; }
        (void)hipGetLastError();
        grid = cus * 1;
        fprintf(stderr, "kernel_launch: grid %d (cus %d, per_cu %d)\n", grid, cus, per_cu);
    }
    if (grid < 0) return;
    Params p{};
    for (int i = 0; i < 16; ++i) p.in[i] = (const float*)d_in[i];
    p.out = (float*)d_out; p.ws = (unsigned char*)d_ws;
    for (int i = 0; i < 8; ++i) p.inv0[i] = (float)std::pow(500000.0, -(double)i / 8.0);
    for (int i = 0; i < 16; ++i) p.inv1[i] = (float)std::pow(500000.0, -(double)i / 16.0);
    p.ph_lo = 0; p.ph_hi = NPH;
    void* args[] = {&p};
    hipError_t e = hipLaunchCooperativeKernel((const void*)fwd_kernel, dim3(grid), dim3(512), args, LDS_BYTES, stream);
    if (e != hipSuccess) fprintf(stderr, "kernel_launch: cooperative launch failed: %s (grid %d)\n", hipGetErrorString(e), grid);
}
```

```cpp
#include <hip/hip_runtime.h>
#include <hip/hip_cooperative_groups.h>
#include <cstdio>
#include <cstdint>
#include <cmath>
namespace cg = cooperative_groups;

#define LAS __attribute__((address_space(3)))
typedef unsigned short bf16_t;
typedef short bf16x8 __attribute__((ext_vector_type(8)));
typedef float f32x4 __attribute__((ext_vector_type(4)));
typedef float f32x2 __attribute__((ext_vector_type(2)));
typedef float f32x16 __attribute__((ext_vector_type(16)));
typedef unsigned u32x4 __attribute__((ext_vector_type(4)));
typedef unsigned u32x2 __attribute__((ext_vector_type(2)));
typedef __bf16 bf16x2_t __attribute__((ext_vector_type(2)));

constexpr int S = 16384, DM = 2048;
constexpr size_t MiB = 1u << 20;
constexpr size_t WS_PROJ = 0;
constexpr size_t WS_VT0 = 192 * MiB;
constexpr size_t WS_VT1 = 296 * MiB;
constexpr size_t WS_H0R0 = 400 * MiB;
constexpr size_t WS_BT0 = 464 * MiB;
constexpr size_t WS_WV0 = 488 * MiB;
constexpr size_t WS_BO0 = 496 * MiB;
constexpr size_t WS_BO1 = 504 * MiB;
constexpr size_t WS_NEED = 512 * MiB;
constexpr size_t DO_MIX = 0;
constexpr size_t DO_BT1 = 64 * MiB;
constexpr size_t DO_WV1 = 101 * MiB;
constexpr size_t DO_TAB0 = 114 * MiB;
constexpr size_t DO_TAB1 = 115 * MiB;
constexpr size_t DO_LSE = 117 * MiB;

constexpr int LD0 = 6144, LD1 = 9472;
constexpr float LOG2E = 1.4426950408889634f;
constexpr float SC128 = 0.08838834764831845f * 1.4426950408889634f;
constexpr float SC64 = 0.125f * 1.4426950408889634f;

struct Params {
    const float* in[16];
    float* out; unsigned char* ws;
    float inv0[8]; float inv1[16];
    int ph_lo, ph_hi;
};
#if defined(__HIP_DEVICE_COMPILE__)
typedef __attribute__((address_space(4))) const Params KParams;
#else
typedef const Params KParams;
#endif

__device__ __forceinline__ unsigned cvtpk(float lo, float hi) { f32x2 v = {lo, hi}; bf16x2_t b = __builtin_convertvector(v, bf16x2_t); return __builtin_bit_cast(unsigned, b); }
__device__ __forceinline__ float bf2f(unsigned short b) { return __uint_as_float(((unsigned)b) << 16); }
__device__ __forceinline__ float bflo(unsigned w) { return __uint_as_float(w << 16); }
__device__ __forceinline__ float bfhi(unsigned w) { return __uint_as_float(w & 0xffff0000u); }
__device__ __forceinline__ float xhalf_sum(float v) { auto rr = __builtin_amdgcn_permlane32_swap(__float_as_uint(v), __float_as_uint(v), false, false); return __uint_as_float(rr[0]) + __uint_as_float(rr[1]); }
__device__ __forceinline__ float wave_sum(float v) {
#pragma unroll
    for (int o = 1; o < 32; o <<= 1) v += __shfl_xor(v, o);
    { auto rr = __builtin_amdgcn_permlane32_swap(__float_as_uint(v), __float_as_uint(v), false, false); v = __uint_as_float(rr[0]) + __uint_as_float(rr[1]); }
    return v;
}
__device__ __forceinline__ float silu_f(float x) { return x * __builtin_amdgcn_rcpf(1.0f + __builtin_amdgcn_exp2f(-x * LOG2E)); }

namespace pg8 {
constexpr int BM = 256, BK = 64, HALF = 128, HTB = HALF * BK * 2, STAGE_BYTES = 8 * HTB, NXCD = 8, WGM = 8;
__host__ __device__ __forceinline__ int lds_byte(int r, int c) { const int st = (r >> 4) * 2 + (c >> 5), rr = r & 15, cc = c & 31, ob = rr * 64 + cc * 2; return st * 1024 + (ob ^ (((ob >> 9) & 1) << 5)); }
__host__ __device__ __forceinline__ void stage_rc(int b, int& R, int& C) { const int st = b / 1024, sb = b % 1024, swz = sb ^ (((sb >> 9) & 1) << 5); R = (st >> 1) * 16 + swz / 64; C = (st & 1) * 32 + (swz % 64) / 2; }
__host__ __device__ __forceinline__ int perm32(int rho) { const int n = rho >> 4, i = rho & 15; return 8 * (i >> 2) + 4 * n + (i & 3); }

struct Unit { int pm, pn; };
struct Gemm { const bf16_t* A; const bf16_t* Bt; int M, N, K; int bdil; };

struct StaticOrder {
    int nM, nN, nwg, G, c;
    __device__ void init(int M, int N, int G_, int c_) { nM = M / BM; nN = N / BM; nwg = nM * nN; G = G_; c = c_; }
    __device__ bool next(int i, Unit& u) const {
        const long L = (long)i * G + c; if (L >= nwg) return false;
        int wgid = (int)L; { const int q = nwg / NXCD, r = nwg % NXCD, xcd = wgid % NXCD, off = wgid / NXCD; wgid = (xcd < r ? xcd * (q + 1) : r * (q + 1) + (xcd - r) * q) + off; }
        const int nig = WGM * nN, gid = wgid / nig, fm = gid * WGM, gsz = (nM - fm) < WGM ? (nM - fm) : WGM;
        u.pm = fm + ((wgid % nig) % gsz); u.pn = (wgid % nig) / gsz; return true;
    }
};


struct EpiMain {
    static constexpr bool PERM = true;
    bf16_t* O; int ldc; const float* tab; int layer; unsigned* kinf;
    __device__ __forceinline__ void operator()(const f32x4 (&acc)[2][2][4][2], const Unit& u, int wr, int wc, int fr, int fq) const {
#pragma unroll
        for (int bj = 0; bj < 2; ++bj) {
            const int blk = 2 * u.pn + bj;
            const bool do_kmax = (layer == 0) && (blk >= 32) && (blk < 40);
            float amax = 0.f;
            int rope = 0; float sc = 1.f;
            if (layer == 0) { if (blk < 8) sc = SC128; else if (blk >= 24 && blk < 32) { rope = 1; sc = SC64; } else if (blk >= 32 && blk < 40) rope = 1; }
            else { if (blk < 24) { rope = 2; sc = SC128; } else if (blk < 48) rope = 2; else if (blk >= 56 && blk < 64) { rope = 2; sc = SC128; } else if (blk >= 64 && blk < 66) rope = 2; }
            const bool do_rope = (rope == 1 && (wc & 1) == 0) || (rope == 2 && wc == 0);
            const int col0 = u.pn * BM + bj * HALF + wc * 32 + 8 * fq;
#pragma unroll
            for (int ai = 0; ai < 2; ++ai)
#pragma unroll
                for (int m = 0; m < 4; ++m) {
                    const int row = u.pm * BM + ai * HALF + wr * 64 + m * 16 + fr;
                    float v[8];
#pragma unroll
                    for (int k = 0; k < 4; ++k) { v[k] = acc[ai][bj][m][0][k]; v[4 + k] = acc[ai][bj][m][1][k]; }
                    if (do_rope) {
                        const int xm = (rope == 1) ? 16 : 32;
                        float pv[8];
#pragma unroll
                        for (int k = 0; k < 8; ++k) pv[k] = __shfl_xor(v[k], xm);
                        const bool act = (rope == 1) ? (fq < 2) : true;
                        const bool isx1 = (rope == 1) ? (fq == 0) : (fq < 2);
                        const float* tp = (rope == 1) ? (tab + ((size_t)row * 8) * 2) : (tab + ((size_t)row * 16 + 8 * (fq & 1)) * 2);
                        f32x4 t0 = *(const f32x4*)(tp), t1 = *(const f32x4*)(tp + 4), t2 = *(const f32x4*)(tp + 8), t3 = *(const f32x4*)(tp + 12);
                        const float cs[8] = {t0[0], t0[2], t1[0], t1[2], t2[0], t2[2], t3[0], t3[2]};
                        const float sn[8] = {t0[1], t0[3], t1[1], t1[3], t2[1], t2[3], t3[1], t3[3]};
                        if (act) {
#pragma unroll
                            for (int k = 0; k < 8; ++k) v[k] = isx1 ? (v[k] * cs[k] - pv[k] * sn[k]) : (v[k] * cs[k] + pv[k] * sn[k]);
                        }
                    }
                    if (do_kmax) {
#pragma unroll
                        for (int k = 0; k < 8; ++k) amax = fmaxf(amax, fabsf(v[k]));
                    }
                    u32x4 w; w.x = cvtpk(v[0] * sc, v[1] * sc); w.y = cvtpk(v[2] * sc, v[3] * sc); w.z = cvtpk(v[4] * sc, v[5] * sc); w.w = cvtpk(v[6] * sc, v[7] * sc);
                    *(u32x4*)(O + (size_t)row * ldc + col0) = w;
                }
            if (do_kmax) {
#pragma unroll
                for (int o = 1; o < 64; o <<= 1) amax = fmaxf(amax, __shfl_xor(amax, o));
                if (fr == 0 && fq == 0) atomicMax(kinf + (blk - 32) * 2 + (wc >> 1), __float_as_uint(amax));
            }
        }
    }
};
struct EpiVt {
    static constexpr bool PERM = true;
    bf16_t* O; int dil;
    __device__ __forceinline__ void operator()(const f32x4 (&acc)[2][2][4][2], const Unit& u, int wr, int wc, int fr, int fq) const {
        const int W = 256 / dil, L = S / dil;
#pragma unroll
        for (int ai = 0; ai < 2; ++ai)
#pragma unroll
            for (int m = 0; m < 4; ++m) {
                const int row = u.pm * BM + ai * HALF + wr * 64 + m * 16 + fr;
#pragma unroll
                for (int bj = 0; bj < 2; ++bj) {
                    const int n0 = bj * HALF + wc * 32 + 8 * fq, c = n0 / W, ll = n0 % W;
                    const f32x4 v0 = acc[ai][bj][m][0], v1 = acc[ai][bj][m][1];
                    u32x4 w; w.x = cvtpk(v0[0], v0[1]); w.y = cvtpk(v0[2], v0[3]); w.z = cvtpk(v1[0], v1[1]); w.w = cvtpk(v1[2], v1[3]);
                    *(u32x4*)(O + (size_t)row * S + (size_t)c * L + u.pn * W + ll) = w;
                }
            }
    }
};
struct EpiF32 {
    static constexpr bool PERM = true;
    bf16_t* O; int ldc;
    __device__ __forceinline__ void operator()(const f32x4 (&acc)[2][2][4][2], const Unit& u, int wr, int wc, int fr, int fq) const {
#pragma unroll
        for (int ai = 0; ai < 2; ++ai)
#pragma unroll
            for (int m = 0; m < 4; ++m) {
                const int row = u.pm * BM + ai * HALF + wr * 64 + m * 16 + fr;
#pragma unroll
                for (int bj = 0; bj < 2; ++bj) {
                    const f32x4 v0 = acc[ai][bj][m][0], v1 = acc[ai][bj][m][1];
                    u32x4 w; w.x = cvtpk(v0[0], v0[1]); w.y = cvtpk(v0[2], v0[3]); w.z = cvtpk(v1[0], v1[1]); w.w = cvtpk(v1[2], v1[3]);
                    *(u32x4*)(O + (size_t)row * ldc + u.pn * BM + bj * HALF + wc * 32 + 8 * fq) = w;
                }
            }
    }
};

template <class Epi>
__device__ __forceinline__ void gemm_phase(LAS unsigned char* lds, const Gemm g, const StaticOrder& S_, const Epi& E, const int tid) {
    const int wid = __builtin_amdgcn_readfirstlane(tid >> 6), lane = tid & 63, wr = wid >> 2, wc = wid & 3, fr = lane & 15, fq = lane >> 4;
    const int K = g.K, nt = K / BK;
    unsigned voffA[2], voffB0[2], voffB1[2];
    {
        const int Wd = 256 / g.bdil;
#pragma unroll
        for (int i = 0; i < 2; ++i) { int R, C; stage_rc(tid * 16 + i * 8192, R, C); const int Rb = Epi::PERM ? ((R & ~31) + perm32(R & 31)) : R;
            voffA[i] = (unsigned)(R * K + C) * 2u;
            const int n0 = Rb, n1 = 128 + Rb;
            voffB0[i] = (unsigned)(((n0 % Wd) * g.bdil + n0 / Wd) * K + C) * 2u;
            voffB1[i] = (unsigned)(((n1 % Wd) * g.bdil + n1 / Wd) * K + C) * 2u; }
    }
    const size_t kstep = (size_t)(BK * 2);
    const size_t hstep = (size_t)HALF * K * 2;
    const size_t tstep = 2 * hstep;
    const unsigned ldsw = (unsigned)wid * 1024u;
    const int aoff = lds_byte(wr * 64 + fr, fq * 8), boff = lds_byte(wc * 32 + fr, fq * 8);
#define PG8_SA(b, h) (((b) * 2 + (h)) * HTB)
#define PG8_SB(b, h) ((4 + (b) * 2 + (h)) * HTB)
#define PG8_STAGE(bufoff, gbase, voff) do { _Pragma("unroll") for (int _i = 0; _i < 2; ++_i) \
        __builtin_amdgcn_global_load_lds((const unsigned*)((const char*)(gbase) + (voff)[_i]), (LAS unsigned*)(lds + (bufoff) + ldsw + _i * 8192), 16, 0, 0); } while (0)
#define PG8_LDA(dst, b, h) do { _Pragma("unroll") for (int m = 0; m < 4; ++m) _Pragma("unroll") for (int k = 0; k < 2; ++k) dst[m][k] = *(const LAS bf16x8*)(lds + PG8_SA(b, h) + aoff + m * 2048 + k * 1024); } while (0)
#define PG8_LDB(dst, b, h) do { _Pragma("unroll") for (int n = 0; n < 2; ++n) _Pragma("unroll") for (int k = 0; k < 2; ++k) dst[n][k] = *(const LAS bf16x8*)(lds + PG8_SB(b, h) + boff + n * 2048 + k * 1024); } while (0)
#define PG8_MMA(ai, bj, At, Bt) do { __builtin_amdgcn_s_setprio(1); _Pragma("unroll") for (int m = 0; m < 4; ++m) _Pragma("unroll") for (int n = 0; n < 2; ++n) _Pragma("unroll") for (int k = 0; k < 2; ++k) \
        acc[ai][bj][m][n] = __builtin_amdgcn_mfma_f32_16x16x32_bf16(Bt[n][k], At[m][k], acc[ai][bj][m][n], 0, 0, 0); __builtin_amdgcn_s_setprio(0); } while (0)
#define PG8_WAIT_V(n) asm volatile("s_waitcnt vmcnt(" #n ")" ::: "memory")
#define PG8_WAIT_L(n) asm volatile("s_waitcnt lgkmcnt(" #n ")" ::: "memory")
#define PG8_BAR __builtin_amdgcn_s_barrier()
#define PG8_SCHED __builtin_amdgcn_sched_barrier(0)
    Unit cur, nxt; int ui = 0;
    if (!S_.next(0, cur)) return;
    f32x4 acc[2][2][4][2];
#pragma unroll
    for (int a = 0; a < 2; ++a)
#pragma unroll
        for (int b = 0; b < 2; ++b)
#pragma unroll
            for (int m = 0; m < 4; ++m)
#pragma unroll
                for (int n = 0; n < 2; ++n) acc[a][b][m][n] = (f32x4){0.f, 0.f, 0.f, 0.f};
    bf16x8 At[4][2], B0[2][2], B1[2][2];
    const char* cA = (const char*)g.A + (size_t)cur.pm * tstep; const char* cB = (const char*)g.Bt + (size_t)cur.pn * tstep;
    PG8_STAGE(PG8_SB(0, 0), cB, voffB0); PG8_STAGE(PG8_SB(0, 1), cB, voffB1); PG8_STAGE(PG8_SA(0, 0), cA, voffA); PG8_STAGE(PG8_SA(0, 1), cA + hstep, voffA);
    if (wr == 1) PG8_BAR;
    PG8_WAIT_V(2); PG8_BAR;
    PG8_STAGE(PG8_SB(1, 0), cB + kstep, voffB0); PG8_STAGE(PG8_SA(1, 0), cA + kstep, voffA); PG8_STAGE(PG8_SB(1, 1), cB + kstep, voffB1);
    PG8_WAIT_V(6); PG8_BAR;
    for (;;) {
        const bool has_next = S_.next(ui + 1, nxt);
        const char* nA = has_next ? (const char*)g.A + (size_t)nxt.pm * tstep : cA; const char* nB = has_next ? (const char*)g.Bt + (size_t)nxt.pn * tstep : cB;
        for (int t = 0; t < nt; t += 2) {
            const bool last = (t == nt - 2);
            const char* a1 = cA + (size_t)(t + 1) * kstep;
            const char* a2 = last ? nA : cA + (size_t)(t + 2) * kstep; const char* b2 = last ? nB : cB + (size_t)(t + 2) * kstep;
            const char* a3 = a2 + kstep; const char* b3 = b2 + kstep;
            PG8_LDB(B0, 0, 0); PG8_LDB(B1, 0, 1); PG8_SCHED; PG8_LDA(At, 0, 0); PG8_STAGE(PG8_SA(1, 1), a1 + hstep, voffA);
            PG8_WAIT_V(8); PG8_WAIT_L(0); PG8_BAR; PG8_MMA(0, 0, At, B0); PG8_MMA(0, 1, At, B1); PG8_BAR; PG8_SCHED;
            PG8_LDA(At, 0, 1); PG8_STAGE(PG8_SB(0, 0), b2, voffB0); PG8_STAGE(PG8_SB(0, 1), b2, voffB1); PG8_STAGE(PG8_SA(0, 0), a2, voffA);
            PG8_WAIT_V(8); PG8_WAIT_L(0); PG8_BAR; PG8_MMA(1, 0, At, B0); PG8_MMA(1, 1, At, B1); PG8_BAR; PG8_SCHED;
            PG8_LDB(B0, 1, 0); PG8_LDB(B1, 1, 1); PG8_SCHED; PG8_LDA(At, 1, 0); PG8_STAGE(PG8_SA(0, 1), a2 + hstep, voffA);
            PG8_WAIT_V(8); PG8_WAIT_L(0); PG8_BAR; PG8_MMA(0, 0, At, B0); PG8_MMA(0, 1, At, B1); PG8_BAR; PG8_SCHED;
            PG8_LDA(At, 1, 1); PG8_STAGE(PG8_SB(1, 0), b3, voffB0); PG8_STAGE(PG8_SB(1, 1), b3, voffB1); PG8_STAGE(PG8_SA(1, 0), a3, voffA);
            PG8_WAIT_V(8); PG8_WAIT_L(0); PG8_BAR; PG8_MMA(1, 0, At, B0); PG8_MMA(1, 1, At, B1); PG8_BAR; PG8_SCHED;
        }
        if (wr == 0) PG8_BAR;
        E(acc, cur, wr, wc, fr, fq);
        if (!has_next) break;
#pragma unroll
        for (int a = 0; a < 2; ++a)
#pragma unroll
            for (int b = 0; b < 2; ++b)
#pragma unroll
                for (int m = 0; m < 4; ++m)
#pragma unroll
                    for (int n = 0; n < 2; ++n) acc[a][b][m][n] = (f32x4){0.f, 0.f, 0.f, 0.f};
        cur = nxt; cA = nA; cB = nB; ++ui;
        if (wr == 1) PG8_BAR;
    }
    PG8_WAIT_V(0);
    PG8_BAR;
#undef PG8_SA
#undef PG8_SB
#undef PG8_STAGE
#undef PG8_LDA
#undef PG8_LDB
#undef PG8_MMA
#undef PG8_WAIT_V
#undef PG8_WAIT_L
#undef PG8_BAR
#undef PG8_SCHED
}
}

constexpr int KBUF = 16384, VBUF = 16384;
constexpr int LOFF_K = 0, LOFF_V = 4 * KBUF, LOFF_Q = 0  , LOFF_RPB = 131072;

__device__ __forceinline__ float max3f(float a, float b, float c) { float r; asm("v_max3_f32 %0, %1, %2, %3" : "=v"(r) : "v"(a), "v"(b), "v"(c)); return r; }
__device__ __forceinline__ float max2f(float a, float b) { float r; asm("v_max_f32_e32 %0, %1, %2" : "=v"(r) : "v"(a), "v"(b)); return r; }
__device__ __forceinline__ float rowmax32(const f32x16& a, const f32x16& b) {
    float m0 = max3f(a[0], a[1], a[2]), m1 = max3f(b[0], b[1], b[2]);
#pragma unroll
    for (int r = 3; r < 15; r += 2) { m0 = max3f(m0, a[r], a[r + 1]); m1 = max3f(m1, b[r], b[r + 1]); }
    float m = max3f(m0, m1, a[15]); m = max2f(m, b[15]);
    auto rr = __builtin_amdgcn_permlane32_swap(__float_as_uint(m), __float_as_uint(m), false, false);
    return max2f(__uint_as_float(rr[0]), __uint_as_float(rr[1]));
}

template <int TYPE>
__device__ __forceinline__ void attn_unit(const KParams& P, const int u, LAS unsigned char* lds, const float lam, const int tid) {
    constexpr bool CS = (TYPE == 1);
    constexpr int ND = CS ? 4 : 8;
    const int lane = tid & 63, wave = __builtin_amdgcn_readfirstlane(tid >> 6), i32 = lane & 31, kh = lane >> 5;
    const int comp = CS ? (wave & 1) : 0, qblk = CS ? (wave >> 1) : wave;
    unsigned char* ws = P.ws; unsigned char* ob = (unsigned char*)P.out;
    const bf16_t* proj = (const bf16_t*)(ws + WS_PROJ);
    const bf16_t *Qp, *Kp, *Vtp; size_t rs; int ql0, ks0, nt, half = 0, h;
    int a_r0 = 0, a_Rfirst = 0;
    int c_g = 0, c_dil = 1, c_c = 0;
    if constexpr (TYPE == 0) {
        h = u & 7; const int rg = u >> 3; a_r0 = 4 * rg;
        Qp = proj + h * 128; Kp = proj + 1024 + h * 128; Vtp = (const bf16_t*)(ws + WS_VT0) + (size_t)(h * 128) * S; rs = LD0; ql0 = a_r0 * 64;
        int rf = a_r0 - 4; rf = rf < 0 ? 0 : (rf > 248 ? 248 : rf);
        int rl = a_r0 + 3 - 4; rl = rl < 0 ? 0 : (rl > 248 ? 248 : rl); rl += 7;
        a_Rfirst = rf; ks0 = rf * 64; nt = rl - rf + 1;
    } else if constexpr (TYPE == 1) {
        h = u & 7; const int qb = u >> 3;
        Qp = proj + 3072 + h * 128; Kp = proj + 4096 + h * 128; Vtp = (const bf16_t*)(ws + WS_VT0) + (size_t)(1024 + h * 128) * S; rs = LD0; ql0 = 256 * qb; ks0 = 0; nt = S / 64;
    } else if constexpr (TYPE == 2) {
        c_g = u >> 9; const int rem = u & 511; h = rem >> 6; const int j = rem & 63;
        c_dil = (c_g == 0) ? 1 : ((c_g == 1) ? 4 : 16); const int nb = 64 / c_dil; c_c = j / nb; const int lb = j % nb; const int L = S / c_dil;
        Qp = proj + (size_t)c_c * LD1 + c_g * 1024 + h * 128; Kp = proj + (size_t)c_c * LD1 + 3072 + c_g * 1024 + h * 128; rs = (size_t)c_dil * LD1;
        Vtp = (const bf16_t*)(ws + WS_VT1) + (size_t)(c_g * 1024 + h * 128) * S + (size_t)c_c * L;
        ql0 = 256 * lb; half = 64; ks0 = 256 * lb - 64; if (ks0 < 0) ks0 = 0; int e = 256 * lb + 256 + 64; if (e > L) e = L; nt = (e - ks0) / 64;
    } else {
        const int kvh = u & 1; const int qb = u >> 1; h = kvh * 4 + (wave >> 1);
        Qp = proj + 7168 + h * 128; Kp = proj + 8192 + kvh * 128; rs = LD1; Vtp = (const bf16_t*)(ws + WS_VT1) + (size_t)(3072 + kvh * 128) * S;
        ql0 = 64 * qb; half = 128; ks0 = 64 * qb - 128; if (ks0 < 0) ks0 = 0; int e = 64 * qb + 64 + 128; if (e > S) e = S; nt = (e - ks0) / 64;
    }
    const int wq0 = CS ? (ql0 + qblk * 64) : (ql0 + ((TYPE == 3) ? (wave & 1) : qblk) * 32);
    const bf16_t *kg0, *kg1, *vg0, *vg1;
    {
        const int r0_ = 8 * wave + (lane >> 4), r1_ = r0_ + 4, p = lane & 15;
        kg0 = Kp + (size_t)(ks0 + r0_) * rs + ((p ^ (r0_ & 15)) * 8);
        kg1 = Kp + (size_t)(ks0 + r1_) * rs + ((p ^ (r1_ & 15)) * 8);
        const int d0_ = 16 * wave + (lane >> 3), d1_ = d0_ + 8, pv = lane & 7;
        vg0 = Vtp + (size_t)d0_ * S + ks0 + ((pv ^ ((d0_ >> 1) & 7)) * 8);
        vg1 = Vtp + (size_t)d1_ * S + ks0 + ((pv ^ ((d1_ >> 1) & 7)) * 8);
    }
    const size_t ktile = 64 * rs;
    const unsigned dmaw = (unsigned)wave * 2048u;
#define AT_DMA_K(t, b) do { \
        __builtin_amdgcn_global_load_lds((const unsigned*)(kg0 + (size_t)(t) * ktile), (LAS unsigned*)(lds + LOFF_K + (b) * KBUF + dmaw), 16, 0, 0); \
        __builtin_amdgcn_global_load_lds((const unsigned*)(kg1 + (size_t)(t) * ktile), (LAS unsigned*)(lds + LOFF_K + (b) * KBUF + dmaw + 1024), 16, 0, 0); } while (0)
#define AT_DMA_V(t, b) do { \
        __builtin_amdgcn_global_load_lds((const unsigned*)(vg0 + (size_t)(t) * 64), (LAS unsigned*)(lds + LOFF_V + (b) * VBUF + dmaw), 16, 0, 0); \
        __builtin_amdgcn_global_load_lds((const unsigned*)(vg1 + (size_t)(t) * 64), (LAS unsigned*)(lds + LOFF_V + (b) * VBUF + dmaw + 1024), 16, 0, 0); } while (0)
#define AT_DMA(t, b) do { AT_DMA_K(t, b); AT_DMA_V(t, b); } while (0)
    AT_DMA(0, 0);
    if constexpr (CS) { AT_DMA(1, 1); }
    else { if (nt > 1) AT_DMA(1, 1); if (nt > 2) AT_DMA(2, 2); }
    bf16x8 qf[ND];
    {
        const bf16_t* qrow = Qp + (size_t)(wq0 + i32) * rs + comp * 64 + kh * 8;
#pragma unroll
        for (int d0 = 0; d0 < ND; ++d0) qf[d0] = *(const bf16x8*)(qrow + d0 * 16);
    }
    f32x16 OB[4];
    float lrunB = 0.f, qsA = 0.f, qsB = 0.f;
    const int qimg = (wave < 2) ? (49152 + 8192 * wave) : ((wave < 4) ? (114688 + 8192 * (wave - 2)) : (131072 + 8192 * (wave - 4)));
    const int qsw = (i32 >> 1) & 7;
    if constexpr (CS) {
        const bf16_t* qrow2 = Qp + (size_t)(wq0 + 32 + i32) * rs + comp * 64 + kh * 8;
#pragma unroll
        for (int d0 = 0; d0 < 4; ++d0) {
            const bf16x8 qa = qf[d0], qb_ = *(const bf16x8*)(qrow2 + d0 * 16);
#pragma unroll
            for (int j = 0; j < 8; ++j) { qsA += fabsf(bf2f((unsigned short)qa[j])); qsB += fabsf(bf2f((unsigned short)qb_[j])); }
            *(LAS bf16x8*)(lds + qimg + i32 * 128 + (((2 * d0 + kh) ^ qsw) * 16)) = qa;
            *(LAS bf16x8*)(lds + qimg + (32 + i32) * 128 + (((2 * d0 + kh) ^ qsw) * 16)) = qb_;
        }
    }
    LAS float* rpbs = (LAS float*)(lds + LOFF_RPB);
    if constexpr (TYPE == 0) { const float* rpb = P.in[3] + h * 465; for (int idx = tid; idx < 465; idx += 512) rpbs[idx] = rpb[idx] * LOG2E; }
    f32x16 O[4];
#pragma unroll
    for (int d = 0; d < 4; ++d)
#pragma unroll
        for (int r = 0; r < 16; ++r) O[d][r] = 0.f;
    f32x16 negm;
#pragma unroll
    for (int r = 0; r < 16; ++r) negm[r] = 0.f;
    float mrun = 0.f, lrun = 0.f;
    bool first = true;
    const int i32_ = i32;
    asm volatile("s_waitcnt vmcnt(0) lgkmcnt(0)" ::: "memory");
    __syncthreads();
    if constexpr (CS) {
#pragma unroll
        for (int d = 0; d < 4; ++d)
#pragma unroll
            for (int r = 0; r < 16; ++r) OB[d][r] = 0.f;
        float mrefA, mrefB;
        {
            const float kmx = __uint_as_float(((const unsigned*)(ob + DO_LSE))[h * 2 + comp]) * 1.01f;
            mrefA = fmaxf(xhalf_sum(qsA) * kmx - 100.f, 0.f); mrefB = fmaxf(xhalf_sum(qsB) * kmx - 100.f, 0.f);
        }
        const bool anyref = __any((mrefA > 0.f) || (mrefB > 0.f)) != 0;
        int b0 = 0, b1 = 1, b2 = 2;
        for (int t = 0; t < nt; ++t) {
            if (t + 2 < nt) AT_DMA(t + 2, b2);
            int i32 = i32_; asm volatile("" : "+v"(i32));
            const int pi = (i32 & 0x13) | ((i32 & 4) << 1) | ((i32 & 8) >> 1);
            const int xk16 = (((pi & 15) ^ kh) * 16) ^ (comp * 128), xv16 = (((i32 >> 1) & 7) ^ kh) * 16, qsw = (i32 >> 1) & 7;
            const LAS unsigned char* Kb = lds + LOFF_K + b0 * KBUF + pi * 256;
            const LAS unsigned char* Vb = lds + LOFF_V + b0 * VBUF + i32 * 128;
            const LAS unsigned char* QA = lds + qimg + i32 * 128;
            const LAS unsigned char* QB = QA + 32 * 128;
            bf16x8 pa[4], pc[4];
#define B_SCORES(QP, MREF, LACC, PB) do { \
                f32x16 a0, a1; \
                _Pragma("unroll") for (int r = 0; r < 16; ++r) { a0[r] = 0.f; a1[r] = 0.f; } \
                _Pragma("unroll") for (int d0 = 0; d0 < 4; ++d0) { \
                    const bf16x8 k0 = *(const LAS bf16x8*)(Kb + ((32 * d0) ^ xk16)); \
                    const bf16x8 k1 = *(const LAS bf16x8*)(Kb + 8192 + ((32 * d0) ^ xk16)); \
                    const bf16x8 qv = *(const LAS bf16x8*)(QP + (((2 * d0 + kh) ^ qsw) * 16)); \
                    a0 = __builtin_amdgcn_mfma_f32_32x32x16_bf16(k0, qv, a0, 0, 0, 0); a1 = __builtin_amdgcn_mfma_f32_32x32x16_bf16(k1, qv, a1, 0, 0, 0); \
                    if (d0 & 1) __builtin_amdgcn_sched_barrier(0); \
                } \
                if (anyref) { float m_ = MREF; asm volatile("" : "+v"(m_)); _Pragma("unroll") for (int r = 0; r < 16; ++r) { a0[r] -= m_; a1[r] -= m_; } } \
                float s0 = 0.f, s1 = 0.f; \
                _Pragma("unroll") for (int r = 0; r < 16; ++r) { a0[r] = __builtin_amdgcn_exp2f(a0[r]); a1[r] = __builtin_amdgcn_exp2f(a1[r]); s0 += a0[r]; s1 += a1[r]; } \
                LACC += s0 + s1; \
                u32x4 w0, w1, w2, w3; \
                w0.x = cvtpk(a0[0], a0[1]); w0.y = cvtpk(a0[2], a0[3]); w0.z = cvtpk(a0[4], a0[5]); w0.w = cvtpk(a0[6], a0[7]); \
                w1.x = cvtpk(a0[8], a0[9]); w1.y = cvtpk(a0[10], a0[11]); w1.z = cvtpk(a0[12], a0[13]); w1.w = cvtpk(a0[14], a0[15]); \
                w2.x = cvtpk(a1[0], a1[1]); w2.y = cvtpk(a1[2], a1[3]); w2.z = cvtpk(a1[4], a1[5]); w2.w = cvtpk(a1[6], a1[7]); \
                w3.x = cvtpk(a1[8], a1[9]); w3.y = cvtpk(a1[10], a1[11]); w3.z = cvtpk(a1[12], a1[13]); w3.w = cvtpk(a1[14], a1[15]); \
                PB[0] = __builtin_bit_cast(bf16x8, w0); PB[1] = __builtin_bit_cast(bf16x8, w1); PB[2] = __builtin_bit_cast(bf16x8, w2); PB[3] = __builtin_bit_cast(bf16x8, w3); \
                __builtin_amdgcn_sched_barrier(0); } while (0)
            B_SCORES(QA, mrefA, lrun, pa);
            B_SCORES(QB, mrefB, lrunB, pc);
#undef B_SCORES
#pragma unroll
            for (int dblk = 0; dblk < 4; ++dblk) {
#pragma unroll
                for (int kc = 0; kc < 4; ++kc) {
                    const bf16x8 vf = *(const LAS bf16x8*)(Vb + dblk * 4096 + ((32 * kc) ^ xv16));
                    O[dblk] = __builtin_amdgcn_mfma_f32_32x32x16_bf16(vf, pa[kc], O[dblk], 0, 0, 0);
                    OB[dblk] = __builtin_amdgcn_mfma_f32_32x32x16_bf16(vf, pc[kc], OB[dblk], 0, 0, 0);
                }
                __builtin_amdgcn_sched_barrier(0);
            }
            if (t + 2 < nt) asm volatile("s_waitcnt vmcnt(4) lgkmcnt(0)" ::: "memory");
            else asm volatile("s_waitcnt vmcnt(0) lgkmcnt(0)" ::: "memory");
            __builtin_amdgcn_s_barrier();
            asm volatile("" ::: "memory");
            { const int tmp = b0; b0 = b1; b1 = b2; b2 = tmp; }
        }
    } else
    for (int t = 0; t < nt; ++t) {
        const int b = t & 3;
        if (t + 3 < nt) AT_DMA(t + 3, (t + 3) & 3);
        const int ks = ks0 + 64 * t;
        bool skip = false;
        int a_dr = 0;
        if constexpr (TYPE == 0) { const int rq = a_r0 + (wave >> 1); int rsq = rq - 4; rsq = rsq < 0 ? 0 : (rsq > 248 ? 248 : rsq); const int R = a_Rfirst + t; skip = (R < rsq) || (R >= rsq + 8); a_dr = R - rq + 7; }
        if constexpr (TYPE >= 2) { skip = (ks > wq0 + 31 + half) || (ks + 63 < wq0 - half); }
        if (!skip) {
            int i32 = i32_; asm volatile("" : "+v"(i32));
            const int pi = (i32 & 0x13) | ((i32 & 4) << 1) | ((i32 & 8) >> 1);
            const int xk16 = (((pi & 15) ^ kh) * 16) ^ (comp * 128), xv16 = (((i32 >> 1) & 7) ^ kh) * 16;
            const LAS unsigned char* Kb = lds + LOFF_K + b * KBUF + pi * 256;
            const LAS unsigned char* Vb = lds + LOFF_V + b * VBUF + i32 * 128;
            f32x16 s0, s1;
#pragma unroll
            for (int d0 = 0; d0 < ND; ++d0) {
                const bf16x8 k0 = *(const LAS bf16x8*)(Kb + ((32 * d0) ^ xk16));
                const bf16x8 k1 = *(const LAS bf16x8*)(Kb + 8192 + ((32 * d0) ^ xk16));
                if (d0 == 0) {
                    if constexpr (CS) { s0 = __builtin_amdgcn_mfma_f32_32x32x16_bf16(k0, qf[0], negm, 0, 0, 0); s1 = __builtin_amdgcn_mfma_f32_32x32x16_bf16(k1, qf[0], negm, 0, 0, 0); }
                    else { const float ng = -mrun;
#pragma unroll
                        for (int r = 0; r < 16; ++r) { s0[r] = ng; s1[r] = ng; }
                        s0 = __builtin_amdgcn_mfma_f32_32x32x16_bf16(k0, qf[0], s0, 0, 0, 0); s1 = __builtin_amdgcn_mfma_f32_32x32x16_bf16(k1, qf[0], s1, 0, 0, 0); }
                }
                else { s0 = __builtin_amdgcn_mfma_f32_32x32x16_bf16(k0, qf[d0], s0, 0, 0, 0); s1 = __builtin_amdgcn_mfma_f32_32x32x16_bf16(k1, qf[d0], s1, 0, 0, 0); }
                if (d0 & 1) __builtin_amdgcn_sched_barrier(0);
            }
            if constexpr (TYPE == 0) {
                const int cq = 32 * (wave & 1) + i32; int cs_ = cq - 8; cs_ = cs_ < 0 ? 0 : (cs_ > 48 ? 48 : cs_);
                int vb = 8 * kh - cs_; asm volatile("" : "+v"(vb));
                int ib = a_dr * 31 + 8 * kh - cq + 15; asm volatile("" : "+v"(ib));
                const LAS float* rp = rpbs + ib;
#pragma unroll
                for (int r = 0; r < 16; ++r) {
                    const int C0 = 16 * (r >> 3) + (r & 7), C1 = C0 + 32;
                    const float b0 = rp[C0], b1 = rp[C1];
                    s0[r] = ((unsigned)(vb + C0) < 16u) ? (s0[r] + b0) : -INFINITY;
                    s1[r] = ((unsigned)(vb + C1) < 16u) ? (s1[r] + b1) : -INFINITY;
                    if ((r & 3) == 3) __builtin_amdgcn_sched_barrier(0);
                }
            }
            if constexpr (TYPE >= 2) {
                const int base = ks + 8 * kh - (wq0 + i32) + half; const unsigned lim = 2u * (unsigned)half;
#pragma unroll
                for (int r = 0; r < 16; ++r) {
                    const int o0 = 16 * (r >> 3) + (r & 7);
                    if ((unsigned)(base + o0) > lim) s0[r] = -INFINITY;
                    if ((unsigned)(base + o0 + 32) > lim) s1[r] = -INFINITY;
                }
            }
            asm volatile("s_nop 15\n\ts_nop 7" : "+v"(s0), "+v"(s1));
            const float delta = rowmax32(s0, s1);
            if (first) {
                const float dl = (delta > -1e30f) ? delta : 0.f;
                mrun += dl;
#pragma unroll
                for (int r = 0; r < 16; ++r) { s0[r] -= dl; s1[r] -= dl; }
                if constexpr (CS) {
#pragma unroll
                    for (int r = 0; r < 16; ++r) negm[r] = -mrun; }
            } else if (__any(delta > 6.0f)) {
                const float dl = fmaxf(delta, 0.f);
                mrun += dl;
                const float f = __builtin_amdgcn_exp2f(-dl);
                lrun *= f;
#pragma unroll
                for (int r = 0; r < 16; ++r) { s0[r] -= dl; s1[r] -= dl; }
#pragma unroll
                for (int d = 0; d < 4; ++d)
#pragma unroll
                    for (int r = 0; r < 16; ++r) O[d][r] *= f;
                if constexpr (CS) {
#pragma unroll
                    for (int r = 0; r < 16; ++r) negm[r] = -mrun; }
            }
            first = false;
            float sa = 0.f, sb_ = 0.f;
#pragma unroll
            for (int r = 0; r < 16; ++r) { s0[r] = __builtin_amdgcn_exp2f(s0[r]); s1[r] = __builtin_amdgcn_exp2f(s1[r]); sa += s0[r]; sb_ += s1[r]; }
            lrun += sa + sb_;
            bf16x8 pb[4];
            {
                u32x4 w0, w1, w2, w3;
                w0.x = cvtpk(s0[0], s0[1]); w0.y = cvtpk(s0[2], s0[3]); w0.z = cvtpk(s0[4], s0[5]); w0.w = cvtpk(s0[6], s0[7]);
                w1.x = cvtpk(s0[8], s0[9]); w1.y = cvtpk(s0[10], s0[11]); w1.z = cvtpk(s0[12], s0[13]); w1.w = cvtpk(s0[14], s0[15]);
                w2.x = cvtpk(s1[0], s1[1]); w2.y = cvtpk(s1[2], s1[3]); w2.z = cvtpk(s1[4], s1[5]); w2.w = cvtpk(s1[6], s1[7]);
                w3.x = cvtpk(s1[8], s1[9]); w3.y = cvtpk(s1[10], s1[11]); w3.z = cvtpk(s1[12], s1[13]); w3.w = cvtpk(s1[14], s1[15]);
                pb[0] = __builtin_bit_cast(bf16x8, w0); pb[1] = __builtin_bit_cast(bf16x8, w1); pb[2] = __builtin_bit_cast(bf16x8, w2); pb[3] = __builtin_bit_cast(bf16x8, w3);
            }
            __builtin_amdgcn_sched_barrier(0);
#pragma unroll
            for (int dblk = 0; dblk < 4; ++dblk) {
#pragma unroll
                for (int kc = 0; kc < 4; ++kc) {
                    const bf16x8 vf = *(const LAS bf16x8*)(Vb + dblk * 4096 + ((32 * kc) ^ xv16));
                    O[dblk] = __builtin_amdgcn_mfma_f32_32x32x16_bf16(vf, pb[kc], O[dblk], 0, 0, 0);
                }
                if (dblk & 1) __builtin_amdgcn_sched_barrier(0);
            }
        }
        if (t + 3 < nt) asm volatile("s_waitcnt vmcnt(8) lgkmcnt(0)" ::: "memory");
        else if (t + 2 < nt) asm volatile("s_waitcnt vmcnt(4) lgkmcnt(0)" ::: "memory");
        else asm volatile("s_waitcnt vmcnt(0) lgkmcnt(0)" ::: "memory");
        __builtin_amdgcn_s_barrier();
        asm volatile("" ::: "memory");
    }
#undef AT_DMA
#undef AT_DMA_K
#undef AT_DMA_V
    float lt; if constexpr (CS) lt = xhalf_sum(lrun); else lt = lrun + __shfl_xor(lrun, 32);
    const int tq = wq0 + i32;
    if constexpr (TYPE == 0) {
        const float il = 1.0f / lt;
        const bf16_t* grow = proj + (size_t)tq * LD0 + 2048 + h * 128 + 4 * kh;
        bf16_t* orow = (bf16_t*)(ob + DO_MIX) + (size_t)tq * DM + h * 128 + 4 * kh;
#pragma unroll
        for (int dblk = 0; dblk < 4; ++dblk)
#pragma unroll
            for (int g4 = 0; g4 < 4; ++g4) {
                const u32x2 gw = *(const u32x2*)(grow + dblk * 32 + g4 * 8);
                const float o0 = O[dblk][4 * g4 + 0] * il * silu_f(bflo(gw.x)), o1 = O[dblk][4 * g4 + 1] * il * silu_f(bfhi(gw.x));
                const float o2 = O[dblk][4 * g4 + 2] * il * silu_f(bflo(gw.y)), o3 = O[dblk][4 * g4 + 3] * il * silu_f(bfhi(gw.y));
                u32x2 w; w.x = cvtpk(o0, o1); w.y = cvtpk(o2, o3);
                *(u32x2*)(orow + dblk * 32 + g4 * 8) = w;
                if (g4 & 1) __builtin_amdgcn_sched_barrier(0);
            }
    } else if constexpr (TYPE == 1) {
        LAS float* X = (LAS float*)(lds + LOFF_Q) + (size_t)(qblk * 32 + i32) * 132 + 4 * kh;
#define B_FIN_PASS(OACC, LTP, ROWOFF) do { \
            const float ltp_ = (LTP); \
            if (comp == 1) { \
                const float f1 = lam / ltp_; \
                _Pragma("unroll") for (int dblk = 0; dblk < 4; ++dblk) _Pragma("unroll") for (int g4 = 0; g4 < 4; ++g4) \
                    *(LAS f32x4*)(X + dblk * 32 + g4 * 8) = (f32x4){OACC[dblk][4 * g4 + 0] * f1, OACC[dblk][4 * g4 + 1] * f1, OACC[dblk][4 * g4 + 2] * f1, OACC[dblk][4 * g4 + 3] * f1}; \
            } \
            asm volatile("s_waitcnt lgkmcnt(0)" ::: "memory"); \
            __syncthreads(); \
            if (comp == 0) { \
                const float il0 = 1.0f / ltp_; \
                float ss = 0.f; \
                _Pragma("unroll") for (int dblk = 0; dblk < 4; ++dblk) _Pragma("unroll") for (int g4 = 0; g4 < 4; ++g4) { \
                    const f32x4 x1 = *(const LAS f32x4*)(X + dblk * 32 + g4 * 8); \
                    _Pragma("unroll") for (int j = 0; j < 4; ++j) { const float o = OACC[dblk][4 * g4 + j] * il0 - x1[j]; OACC[dblk][4 * g4 + j] = o; ss += o * o; } \
                } \
                ss = xhalf_sum(ss); \
                const float rn = rsqrtf(ss * (1.0f / 128.0f) + 1e-6f) * 0.8f; \
                int i32f_ = i32_; asm volatile("" : "+v"(i32f_)); const size_t tok = (size_t)(wq0 + (ROWOFF) + i32f_); \
                const bf16_t* grow = proj + tok * LD0 + 5120 + h * 128 + 4 * kh; \
                bf16_t* orow = (bf16_t*)(ob + DO_MIX) + tok * DM + 1024 + h * 128 + 4 * kh; \
                const float* sg = P.in[8] + 4 * kh; \
                _Pragma("unroll") for (int dblk = 0; dblk < 4; ++dblk) _Pragma("unroll") for (int g4 = 0; g4 < 4; ++g4) { \
                    const u32x2 gw = *(const u32x2*)(grow + dblk * 32 + g4 * 8); \
                    const f32x4 sv = *(const f32x4*)(sg + dblk * 32 + g4 * 8); \
                    const float o0 = OACC[dblk][4 * g4 + 0] * rn * sv[0] * silu_f(bflo(gw.x)), o1 = OACC[dblk][4 * g4 + 1] * rn * sv[1] * silu_f(bfhi(gw.x)); \
                    const float o2 = OACC[dblk][4 * g4 + 2] * rn * sv[2] * silu_f(bflo(gw.y)), o3 = OACC[dblk][4 * g4 + 3] * rn * sv[3] * silu_f(bfhi(gw.y)); \
                    u32x2 w; w.x = cvtpk(o0, o1); w.y = cvtpk(o2, o3); \
                    *(u32x2*)(orow + dblk * 32 + g4 * 8) = w; \
                    if (g4 & 1) __builtin_amdgcn_sched_barrier(0); \
                } \
            } \
            asm volatile("s_waitcnt lgkmcnt(0)" ::: "memory"); \
            __syncthreads(); } while (0)
        B_FIN_PASS(O, lt, 0);
        B_FIN_PASS(OB, xhalf_sum(lrunB), 32);
#undef B_FIN_PASS
    } else if constexpr (TYPE == 2) {
        const float il = 1.0f / lt;
        const size_t tok = (size_t)tq * c_dil + c_c;
        bf16_t* orow = (bf16_t*)proj + tok * LD1 + c_g * 1024 + h * 128 + 4 * kh;
#pragma unroll
        for (int dblk = 0; dblk < 4; ++dblk)
#pragma unroll
            for (int g4 = 0; g4 < 4; ++g4) {
                u32x2 w; w.x = cvtpk(O[dblk][4 * g4 + 0] * il, O[dblk][4 * g4 + 1] * il); w.y = cvtpk(O[dblk][4 * g4 + 2] * il, O[dblk][4 * g4 + 3] * il);
                *(u32x2*)(orow + dblk * 32 + g4 * 8) = w;
                if (g4 & 1) __builtin_amdgcn_sched_barrier(0);
            }
        if (kh == 0) ((float*)(ob + DO_LSE))[tok * 24 + c_g * 8 + h] = mrun + __builtin_amdgcn_logf(lt);
    } else {
        const float sk = P.in[13][h] * LOG2E;
        const float il = 1.0f / (lt + __builtin_amdgcn_exp2f(sk - mrun));
        const bf16_t* grow = proj + (size_t)tq * LD1 + 8448 + h * 128 + 4 * kh;
        bf16_t* orow = (bf16_t*)(ob + DO_MIX) + (size_t)tq * DM + 1024 + h * 128 + 4 * kh;
#pragma unroll
        for (int dblk = 0; dblk < 4; ++dblk)
#pragma unroll
            for (int g4 = 0; g4 < 4; ++g4) {
                const u32x2 gw = *(const u32x2*)(grow + dblk * 32 + g4 * 8);
                const float o0 = O[dblk][4 * g4 + 0] * il * silu_f(bflo(gw.x)), o1 = O[dblk][4 * g4 + 1] * il * silu_f(bfhi(gw.x));
                const float o2 = O[dblk][4 * g4 + 2] * il * silu_f(bflo(gw.y)), o3 = O[dblk][4 * g4 + 3] * il * silu_f(bfhi(gw.y));
                u32x2 w; w.x = cvtpk(o0, o1); w.y = cvtpk(o2, o3);
                *(u32x2*)(orow + dblk * 32 + g4 * 8) = w;
                if (g4 & 1) __builtin_amdgcn_sched_barrier(0);
            }
    }
}

__device__ __forceinline__ void transpose_item(const float* W, int ldw, int c0, int nc, bf16_t* dst, int r0, LAS float* scr, int item, int lane) {
    const int nblk = nc / 32, kb = item / nblk, nb = item % nblk, k0 = 64 * kb, n0 = 32 * nb;
#pragma unroll 8
    for (int i = 0; i < 32; ++i) { const int kk = 2 * i + (lane >> 5); scr[kk * 33 + (lane & 31)] = W[(size_t)(k0 + kk) * ldw + c0 + n0 + (lane & 31)]; }
    asm volatile("s_waitcnt lgkmcnt(0)" ::: "memory");
    const int c = lane & 7;
#pragma unroll
    for (int j = 0; j < 4; ++j) { const int n = (lane >> 3) + 8 * j; const LAS float* s = scr + (8 * c) * 33 + n;
        u32x4 o; o.x = cvtpk(s[0 * 33], s[1 * 33]); o.y = cvtpk(s[2 * 33], s[3 * 33]); o.z = cvtpk(s[4 * 33], s[5 * 33]); o.w = cvtpk(s[6 * 33], s[7 * 33]);
        *(u32x4*)(dst + (size_t)(r0 + n0 + n) * DM + k0 + 8 * c) = o; }
    asm volatile("s_waitcnt lgkmcnt(0)" ::: "memory");
}
__device__ __forceinline__ void sincos_d(float ang, float& c, float& s) {
    const double a = (double)ang;
    const double k = __builtin_rint(a * 0.15915494309189535);
    const double r = __builtin_fma(-k, 6.283185307179586, a) - k * 2.4492935982947064e-16;
    const double r2 = r * r;
    double sp = -1.0 / 51090942171709440000.0;
    sp = sp * r2 + 1.0 / 121645100408832000.0;
    sp = sp * r2 - 1.0 / 355687428096000.0;
    sp = sp * r2 + 1.0 / 1307674368000.0;
    sp = sp * r2 - 1.0 / 6227020800.0;
    sp = sp * r2 + 1.0 / 39916800.0;
    sp = sp * r2 - 1.0 / 362880.0;
    sp = sp * r2 + 1.0 / 5040.0;
    sp = sp * r2 - 1.0 / 120.0;
    sp = sp * r2 + 1.0 / 6.0;
    sp = sp * r2 - 1.0;
    s = (float)(-(sp * r));
    double cp = 1.0 / 1124000727777607680000.0;
    cp = cp * r2 - 1.0 / 2432902008176640000.0;
    cp = cp * r2 + 1.0 / 6402373705728000.0;
    cp = cp * r2 - 1.0 / 20922789888000.0;
    cp = cp * r2 + 1.0 / 87178291200.0;
    cp = cp * r2 - 1.0 / 479001600.0;
    cp = cp * r2 + 1.0 / 3628800.0;
    cp = cp * r2 - 1.0 / 40320.0;
    cp = cp * r2 + 1.0 / 720.0;
    cp = cp * r2 - 1.0 / 24.0;
    cp = cp * r2 + 0.5;
    c = (float)(1.0 - cp * r2);
}
__device__ __forceinline__ void rms_row_to_bf16(const float* xrow, const float* g, bf16_t* orow, int lane) {
    const f32x4* xr = (const f32x4*)xrow + lane; const f32x4* gr = (const f32x4*)g + lane;
    f32x4 v[8]; float s = 0.f;
#pragma unroll
    for (int j = 0; j < 8; ++j) { v[j] = xr[64 * j]; s += (v[j].x * v[j].x + v[j].y * v[j].y) + (v[j].z * v[j].z + v[j].w * v[j].w); }
    const float rstd = rsqrtf(wave_sum(s) * (1.f / DM) + 1e-6f);
    u32x2* o8 = (u32x2*)orow + lane;
#pragma unroll
    for (int j = 0; j < 8; ++j) { const f32x4 gg = gr[64 * j]; u32x2 w; w.x = cvtpk(v[j].x * rstd * gg.x, v[j].y * rstd * gg.y); w.y = cvtpk(v[j].z * rstd * gg.z, v[j].w * rstd * gg.w); o8[64 * j] = w; }
}

__device__ unsigned g_bar_word[64];
__device__ __forceinline__ void grid_bar_fast(const unsigned G) {
    asm volatile("s_waitcnt vmcnt(0) lgkmcnt(0)" ::: "memory");
    __syncthreads();
    if (threadIdx.x == 0) {
        __builtin_amdgcn_fence(__ATOMIC_RELEASE, "agent");
        asm volatile("s_waitcnt vmcnt(0)" ::: "memory");
        const unsigned old = __hip_atomic_fetch_add(&g_bar_word[0], 1u, __ATOMIC_RELAXED, __HIP_MEMORY_SCOPE_AGENT);
        const unsigned target = (old / G + 1u) * G;
        while ((int)(__hip_atomic_load(&g_bar_word[0], __ATOMIC_RELAXED, __HIP_MEMORY_SCOPE_AGENT) - target) < 0) __builtin_amdgcn_s_sleep(1);
        __builtin_amdgcn_fence(__ATOMIC_ACQUIRE, "agent");
        asm volatile("s_waitcnt vmcnt(0)" ::: "memory");
    }
    __syncthreads();
}

constexpr int LDS_BYTES = 163840;
constexpr int NPH = 11;

#define GETP(name) const KParams* name##_p = (const KParams*)__builtin_amdgcn_kernarg_segment_ptr(); asm volatile("" : "+s"(name##_p)); const KParams& name = *name##_p;
__global__ void __launch_bounds__(512, 2) fwd_kernel(Params Punused) {
#if defined(__HIP_DEVICE_COMPILE__)
    extern __shared__ __attribute__((aligned(16))) unsigned char lds_raw[];
    LAS unsigned char* lds = (LAS unsigned char*)lds_raw;
    cg::grid_group grid = cg::this_grid();
    const int wave = __builtin_amdgcn_readfirstlane(threadIdx.x >> 6);
#define MYTID(t_) int t_; asm volatile("v_mbcnt_lo_u32_b32 %0, -1, 0\n\tv_mbcnt_hi_u32_b32 %0, -1, %0" : "=v"(t_)); t_ += wave * 64
    const int G = gridDim.x, bx = blockIdx.x;
    const int gw = bx * 8 + wave, NGW = G * 8;
    int ph_lo, ph_hi; unsigned char* ws; unsigned char* ob;
    { GETP(PT); ph_lo = PT.ph_lo; ph_hi = PT.ph_hi; ws = PT.ws; ob = (unsigned char*)PT.out; }
#define IN(k) (ph_lo <= (k) && (k) < ph_hi)
#define SEAM(k) do { if (IN(k) && IN((k) + 1)) { if ((k) == 0) grid.sync(); else grid_bar_fast((unsigned)G); } } while (0)

    if (IN(0)) {
        GETP(P);
        MYTID(tid); const int lane = tid & 63;
        LAS float* scr = (LAS float*)(lds + wave * 16384);
        const float* Win0 = P.in[2]; const float* Wout0 = P.in[9]; const float* Win1 = P.in[12]; const float* Wout1 = P.in[14];
        bf16_t* Bt0 = (bf16_t*)(ws + WS_BT0); bf16_t* Wv0 = (bf16_t*)(ws + WS_WV0); bf16_t* Bo0 = (bf16_t*)(ws + WS_BO0); bf16_t* Bo1 = (bf16_t*)(ws + WS_BO1);
        bf16_t* Bt1 = (bf16_t*)(ob + DO_BT1); bf16_t* Wv1 = (bf16_t*)(ob + DO_WV1);
        constexpr int NIT = 8192 + 12800 + 2048 + 2048;
        for (int it = gw; it < NIT; it += NGW) {
            int r = it;
            if (r < 2048) { transpose_item(Win0, 8192, 0, 2048, Bt0, 0, scr, r, lane); continue; } r -= 2048;
            if (r < 3072) { transpose_item(Win0, 8192, 3072, 3072, Bt0, 2048, scr, r, lane); continue; } r -= 3072;
            if (r < 1024) { transpose_item(Win0, 8192, 7168, 1024, Bt0, 5120, scr, r, lane); continue; } r -= 1024;
            if (r < 1024) { transpose_item(Win0, 8192, 2048, 1024, Wv0, 0, scr, r, lane); continue; } r -= 1024;
            if (r < 1024) { transpose_item(Win0, 8192, 6144, 1024, Wv0, 1024, scr, r, lane); continue; } r -= 1024;
            if (r < 6144) { transpose_item(Win1, 12800, 0, 6144, Bt1, 0, scr, r, lane); continue; } r -= 6144;
            if (r < 2304) { transpose_item(Win1, 12800, 9216, 2304, Bt1, 6144, scr, r, lane); continue; } r -= 2304;
            if (r < 1024) { transpose_item(Win1, 12800, 11776, 1024, Bt1, 8448, scr, r, lane); continue; } r -= 1024;
            if (r < 3072) { transpose_item(Win1, 12800, 6144, 3072, Wv1, 0, scr, r, lane); continue; } r -= 3072;
            if (r < 256) { transpose_item(Win1, 12800, 11520, 256, Wv1, 3072, scr, r, lane); continue; } r -= 256;
            if (r < 2048) { transpose_item(Wout0, 2048, 0, 2048, Bo0, 0, scr, r, lane); continue; } r -= 2048;
            transpose_item(Wout1, 2048, 0, 2048, Bo1, 0, scr, r, lane);
        }
        for (int m = gw; m < S; m += NGW) rms_row_to_bf16(P.in[0] + (size_t)m * DM, P.in[1], (bf16_t*)(ws + WS_H0R0) + (size_t)m * DM, lane);
        if (bx == 0 && tid < 16) ((unsigned*)(ob + DO_LSE))[tid] = 0u;
        float* tab0 = (float*)(ob + DO_TAB0); float* tab1 = (float*)(ob + DO_TAB1);
        for (int idx = bx * 512 + tid; idx < S * 24; idx += G * 512) {
            if (idx < S * 8) { const int pos = idx >> 3, i = idx & 7; float c, s; sincos_d((float)pos * P.inv0[i], c, s); tab0[2 * idx] = c; tab0[2 * idx + 1] = s; }
            else { const int j = idx - S * 8; const int pos = j >> 4, i = j & 15; float c, s; sincos_d((float)pos * P.inv1[i], c, s); tab1[2 * j] = c; tab1[2 * j + 1] = s; }
        }
    }
    SEAM(0);

#pragma clang loop unroll(full)
    for (int layer = 0; layer < 2; ++layer) {
        const int pb = 1 + 5 * layer;
        if (IN(pb)) {
            const bf16_t* hA = layer == 0 ? (const bf16_t*)(ws + WS_H0R0) : (const bf16_t*)(ob + DO_MIX);
            {
                pg8::Gemm g{hA, layer == 0 ? (const bf16_t*)(ws + WS_BT0) : (const bf16_t*)(ob + DO_BT1), S, layer == 0 ? LD0 : LD1, DM, 1};
                pg8::StaticOrder so; so.init(g.M, g.N, G, bx);
                pg8::EpiMain E{(bf16_t*)(ws + WS_PROJ), g.N, layer == 0 ? (const float*)(ob + DO_TAB0) : (const float*)(ob + DO_TAB1), layer, (unsigned*)(ob + DO_LSE)};

#ifndef SKIP_GM
                { MYTID(t_); pg8::gemm_phase<pg8::EpiMain>(lds, g, so, E, t_); }
#endif

            }
            const int ncall = layer == 0 ? 1 : 4;
            for (int q = 0; q < ncall; ++q) {
                const bf16_t* Wv; bf16_t* Vt; int Mv, dil;
                if (layer == 0) { Wv = (const bf16_t*)(ws + WS_WV0); Vt = (bf16_t*)(ws + WS_VT0); Mv = 2048; dil = 1; }
                else if (q < 3) { Wv = (const bf16_t*)(ob + DO_WV1) + (size_t)q * 1024 * DM; Vt = (bf16_t*)(ws + WS_VT1) + (size_t)q * 1024 * S; Mv = 1024; dil = (q == 0) ? 1 : (q == 1 ? 4 : 16); }
                else { Wv = (const bf16_t*)(ob + DO_WV1) + (size_t)3072 * DM; Vt = (bf16_t*)(ws + WS_VT1) + (size_t)3072 * S; Mv = 256; dil = 1; }
                pg8::Gemm g{Wv, hA, Mv, S, DM, dil};
                pg8::StaticOrder so; so.init(g.M, g.N, G, (layer == 1 && q == 3 && G == 256) ? ((bx + 192) & 255) : bx);
                pg8::EpiVt E{Vt, dil};

#ifndef SKIP_GV
                { MYTID(t_); pg8::gemm_phase<pg8::EpiVt>(lds, g, so, E, t_); }
#endif

            }
        }
        SEAM(pb);
        if (IN(pb + 1)) {
            GETP(P);
            if (layer == 0) {
                float lam;
                { MYTID(tl_); const int lane = tl_ & 63; const float a = P.in[4][lane] * P.in[5][lane], b = P.in[6][lane] * P.in[7][lane];
                  lam = __expf(wave_sum(a)) - __expf(wave_sum(b)) + 0.2f; }
#ifndef SKIP_B
                for (int u = bx; u < 512; u += G) { MYTID(t_); attn_unit<1>(P, u, lds, lam, t_); }
#endif
#ifndef SKIP_A
                for (int u = bx; u < 512; u += G) { MYTID(t_); attn_unit<0>(P, u, lds, 0.f, t_); }
#endif
            } else {
#ifndef SKIP_C
                for (int u = bx; u < 1536; u += G) { MYTID(t_); attn_unit<2>(P, u, lds, 0.f, t_); }
#endif
#ifndef SKIP_D
                for (int u = bx; u < 512; u += G) { MYTID(t_); attn_unit<3>(P, u, lds, 0.f, t_); }
#endif
            }
        }
        SEAM(pb + 1);
        if (IN(pb + 2) && layer == 1) {
            const bf16_t* proj = (const bf16_t*)(ws + WS_PROJ); const float* lse = (const float*)(ob + DO_LSE); bf16_t* mix = (bf16_t*)(ob + DO_MIX);
            MYTID(tm_);
            for (int it = bx * 512 + tm_; it < S * 128; it += G * 512) {
                const int t = it >> 7, hh = (it >> 4) & 7, ch = it & 15;
                const float l0 = lse[(size_t)t * 24 + hh], l1 = lse[(size_t)t * 24 + 8 + hh], l2 = lse[(size_t)t * 24 + 16 + hh];
                const float mx = fmaxf(l0, fmaxf(l1, l2));
                float w0 = __builtin_amdgcn_exp2f(l0 - mx), w1 = __builtin_amdgcn_exp2f(l1 - mx), w2 = __builtin_amdgcn_exp2f(l2 - mx);
                const float iw = 1.0f / (w0 + w1 + w2); w0 *= iw; w1 *= iw; w2 *= iw;
                const bf16_t* pr = proj + (size_t)t * LD1 + hh * 128 + ch * 8;
                const u32x4 a0 = *(const u32x4*)pr, a1 = *(const u32x4*)(pr + 1024), a2 = *(const u32x4*)(pr + 2048), gg = *(const u32x4*)(pr + 6144);
                u32x4 o;
#pragma unroll
                for (int k = 0; k < 4; ++k) {
                    const float lo = (w0 * bflo(a0[k]) + w1 * bflo(a1[k]) + w2 * bflo(a2[k])) * silu_f(bflo(gg[k]));
                    const float hi = (w0 * bfhi(a0[k]) + w1 * bfhi(a1[k]) + w2 * bfhi(a2[k])) * silu_f(bfhi(gg[k]));
                    o[k] = cvtpk(lo, hi);
                }
                *(u32x4*)(mix + (size_t)t * DM + hh * 128 + ch * 8) = o;
            }
        }
        if (layer == 1) SEAM(pb + 2);
        if (IN(pb + 3)) {
            pg8::Gemm g{(const bf16_t*)(ob + DO_MIX), layer == 0 ? (const bf16_t*)(ws + WS_BO0) : (const bf16_t*)(ws + WS_BO1), S, DM, DM, 1};
            pg8::StaticOrder so; so.init(g.M, g.N, G, bx);
            pg8::EpiF32 E{(bf16_t*)(ws + WS_PROJ), DM};

#ifndef SKIP_GF
                { MYTID(t_); pg8::gemm_phase<pg8::EpiF32>(lds, g, so, E, t_); }
#endif

        }
        SEAM(pb + 3);
        if (IN(pb + 4)) {
            GETP(P);
            const bf16_t* Y = (const bf16_t*)(ws + WS_PROJ); bf16_t* R0 = (bf16_t*)(ws + WS_H0R0);
            const float* gpost = layer == 0 ? P.in[10] : P.in[15];
            MYTID(tr_); const int lane = tr_ & 63;
            for (int m = gw; m < S; m += NGW) {
                const u32x2* yr = (const u32x2*)(Y + (size_t)m * DM) + lane; const f32x4* xr = (const f32x4*)(P.in[0] + (size_t)m * DM) + lane;
                const f32x4* gp = (const f32x4*)gpost + lane;
                f32x4 v[8]; float s = 0.f;
#pragma unroll
                for (int j = 0; j < 8; ++j) { const u32x2 yw = yr[64 * j]; v[j].x = bflo(yw.x); v[j].y = bfhi(yw.x); v[j].z = bflo(yw.y); v[j].w = bfhi(yw.y); s += (v[j].x * v[j].x + v[j].y * v[j].y) + (v[j].z * v[j].z + v[j].w * v[j].w); }
                const float rstd = rsqrtf(wave_sum(s) * (1.f / DM) + 1e-6f);
                if (layer == 0) {
                    u32x2* r8 = (u32x2*)(R0 + (size_t)m * DM) + lane; float s1 = 0.f;
#pragma unroll
                    for (int j = 0; j < 8; ++j) { const f32x4 gg = gp[64 * j]; const f32x4 xx = xr[64 * j];
                        u32x2 w; w.x = cvtpk(v[j].x * rstd * gg.x, v[j].y * rstd * gg.y); w.y = cvtpk(v[j].z * rstd * gg.z, v[j].w * rstd * gg.w); r8[64 * j] = w;
                        v[j].x = xx.x + bflo(w.x); v[j].y = xx.y + bfhi(w.x); v[j].z = xx.z + bflo(w.y); v[j].w = xx.w + bfhi(w.y);
                        s1 += (v[j].x * v[j].x + v[j].y * v[j].y) + (v[j].z * v[j].z + v[j].w * v[j].w); }
                    const float rstd1 = rsqrtf(wave_sum(s1) * (1.f / DM) + 1e-6f);
                    const f32x4* g1 = (const f32x4*)P.in[11] + lane; u32x2* h8 = (u32x2*)((bf16_t*)(ob + DO_MIX) + (size_t)m * DM) + lane;
#pragma unroll
                    for (int j = 0; j < 8; ++j) { const f32x4 gg = g1[64 * j]; u32x2 w; w.x = cvtpk(v[j].x * rstd1 * gg.x, v[j].y * rstd1 * gg.y); w.y = cvtpk(v[j].z * rstd1 * gg.z, v[j].w * rstd1 * gg.w); h8[64 * j] = w; }
                } else {
                    const u32x2* r8 = (const u32x2*)(R0 + (size_t)m * DM) + lane; f32x4* o4 = (f32x4*)(P.out + (size_t)m * DM) + lane;
#pragma unroll
                    for (int j = 0; j < 8; ++j) { const f32x4 gg = gp[64 * j]; const f32x4 xx = xr[64 * j]; const u32x2 w = r8[64 * j];
                        f32x4 o; o.x = xx.x + bflo(w.x) + v[j].x * rstd * gg.x; o.y = xx.y + bfhi(w.x) + v[j].y * rstd * gg.y; o.z = xx.z + bflo(w.y) + v[j].z * rstd * gg.z; o.w = xx.w + bfhi(w.y) + v[j].w * rstd * gg.w;
                        o4[64 * j] = o; }
                }
            }
        }
        if (layer == 0) SEAM(pb + 4);
    }
#undef IN
#undef SEAM
#endif
}

extern "C" void kernel_launch(void* const* d_in, const int* in_sizes, int n_in, void* d_out, int out_size, void* d_ws, size_t ws_size, hipStream_t stream) {
    static int grid = 0;
    if (grid == 0) {
        if (n_in != 16 || out_size != S * DM || ws_size < WS_NEED) { fprintf(stderr, "kernel_launch: unexpected shapes: n_in %d out %d ws %zu\n", n_in, out_size, ws_size); grid = -1; return; }
        int dev = 0, cus = 0, per_cu = 0;
        hipGetDevice(&dev);
        hipDeviceGetAttribute(&cus, hipDeviceAttributeMultiprocessorCount, dev);
        if (hipFuncSetAttribute((const void*)fwd_kernel, hipFuncAttributeMaxDynamicSharedMemorySize, LDS_BYTES) != hipSuccess) { fprintf(stderr, "kernel_launch: hipFuncSetAttribute failed\n"); grid = -1; return; }
        if (hipOccupancyMaxActiveBlocksPerMultiprocessor(&per_cu, (const void*)fwd_kernel, 512, LDS_BYTES) != hipSuccess || per_cu < 1) { fprintf(stderr, "kernel_launch: occupancy query says %d\n", per_cu); per_cu = 1; }
        (void)hipGetLastError();
        grid = cus * 1;
        fprintf(stderr, "kernel_launch: grid %d (cus %d, per_cu %d)\n", grid, cus, per_cu);
    }
    if (grid < 0) return;
    Params p{};
    for (int i = 0; i < 16; ++i) p.in[i] = (const float*)d_in[i];
    p.out = (float*)d_out; p.ws = (unsigned char*)d_ws;
    for (int i = 0; i < 8; ++i) p.inv0[i] = (float)std::pow(500000.0, -(double)i / 8.0);
    for (int i = 0; i < 16; ++i) p.inv1[i] = (float)std::pow(500000.0, -(double)i / 16.0);
    p.ph_lo = 0; p.ph_hi = NPH;
    void* args[] = {&p};
    hipError_t e = hipLaunchCooperativeKernel((const void*)fwd_kernel, dim3(grid), dim3(512), args, LDS_BYTES, stream);
    if (e != hipSuccess) fprintf(stderr, "kernel_launch: cooperative launch failed: %s (grid %d)\n", hipGetErrorString(e), grid);
}
```
